# Optimizing an MI355X kernel written in HIP

```python
import jax
import jax.numpy as jnp
from jax import lax
import numpy as np

D_MODEL = 2048
BATCH = 2
SEQ = 4096
DEPTH = 4
DEC_BATCH = 8
DEC_SEQ = 1
PAST_LEN = 16384
PAGE_SIZE = 128

HEAD_DIM = 128
BRANCH_WIDTH = D_MODEL // 4
POOL_WIDTH = BRANCH_WIDTH
POOL_WINDOWS = (2, 4, 8, 16)
POOL_GDIM = POOL_WIDTH // len(POOL_WINDOWS)
POOL_BUF = max(POOL_WINDOWS) - 1
DIL_PAIRS = ((128, 1), (512, 4), (2048, 16))
N_DIL = len(DIL_PAIRS)
DIL_HEADS = BRANCH_WIDTH // HEAD_DIM
DIL_WIDTH = DIL_HEADS * HEAD_DIM
MEM_LEN = 256
MEM_HEADS = 4
MEM_WIDTH = MEM_HEADS * HEAD_DIM
MIX_WIDTH = POOL_WIDTH + DIL_WIDTH + MEM_WIDTH
IN_COLS = 2 * POOL_WIDTH + 3 * N_DIL * DIL_WIDTH + DIL_WIDTH + 2 * MEM_WIDTH
BAND_BLOCK = 128
EPS = 1e-6
ATTN_SCALE = HEAD_DIM ** -0.5

kernel_name = 'hybrid_pool_dilated_memory_step'


def rms_norm(x, g):
    xf = x.astype(jnp.float32)
    y = xf * lax.rsqrt(jnp.mean(xf * xf, axis=-1, keepdims=True) + EPS)
    return (y * g.astype(jnp.float32)).astype(x.dtype)


def pool_mix(u_ext, pos0, pool_w, pool_scale):
    B, E, C = u_ext.shape
    L = E - POOL_BUF
    uf = u_ext.astype(jnp.float32)
    cs = jnp.concatenate([jnp.zeros((B, 1, C), jnp.float32), jnp.cumsum(uf, axis=1)], axis=1)
    end = cs[:, POOL_BUF + 1:]
    u_new = uf[:, POOL_BUF:]
    pos = pos0 + jnp.arange(L)
    outs = []
    for gi, w in enumerate(POOL_WINDOWS):
        sl = slice(gi * POOL_GDIM, (gi + 1) * POOL_GDIM)
        start = cs[:, POOL_BUF + 1 - w: POOL_BUF + 1 - w + L, sl]
        cnt = jnp.minimum(w, pos + 1).astype(jnp.float32)[None, :, None]
        d = (end[..., sl] - start) / cnt - u_new[..., sl]
        outs.append(jnp.einsum('blc,cd->bld', d, pool_w[gi].astype(jnp.float32)))
    y = jnp.concatenate(outs, axis=-1) * pool_scale.astype(jnp.float32)
    return y.astype(u_ext.dtype)


def band_attention(q, k, v, back):
    N, T, H, Dh = q.shape
    nb = -(-T // BAND_BLOCK)
    Tp = nb * BAND_BLOCK
    qb = jnp.pad(q, ((0, 0), (0, Tp - T), (0, 0), (0, 0))).reshape(N, nb, BAND_BLOCK, H, Dh)
    kpad = ((0, 0), (BAND_BLOCK, Tp - T), (0, 0), (0, 0))
    kp = jnp.pad(k, kpad).reshape(N, nb + 1, BAND_BLOCK, H, Dh)
    vp = jnp.pad(v, kpad).reshape(N, nb + 1, BAND_BLOCK, H, Dh)
    kb = jnp.concatenate([kp[:, :-1], kp[:, 1:]], axis=2)
    vb = jnp.concatenate([vp[:, :-1], vp[:, 1:]], axis=2)
    s = jnp.einsum('nbqhd,nbkhd->nbhqk', qb, kb, preferred_element_type=jnp.float32) * ATTN_SCALE
    qi = BAND_BLOCK + jnp.arange(BAND_BLOCK)[:, None]
    kj = jnp.arange(2 * BAND_BLOCK)[None, :]
    dist = qi - kj
    kabs = (jnp.arange(nb)[:, None, None] - 1) * BAND_BLOCK + kj[None]
    valid = (dist >= 0) & (dist <= back) & (kabs >= 0)
    s = jnp.where(valid[None, :, None], s, -jnp.inf)
    lse = jax.nn.logsumexp(s, axis=-1)
    p = jnp.exp(s - lse[..., None])
    o = jnp.einsum('nbhqk,nbkhd->nbqhd', p.astype(vb.dtype), vb)
    o = o.reshape(N, Tp, H, Dh)[:, :T]
    lse = lse.transpose(0, 1, 3, 2).reshape(N, Tp, H)[:, :T]
    return o, lse


def dilated_prompt(q, k, v, window, dil):
    B, L, H, Dh = q.shape
    T = L // dil
    def to_sub(a):
        return a.reshape(B, T, dil, H, Dh).transpose(0, 2, 1, 3, 4).reshape(B * dil, T, H, Dh)
    o, lse = band_attention(to_sub(q), to_sub(k), to_sub(v), window // dil)
    o = o.reshape(B, dil, T, H, Dh).transpose(0, 2, 1, 3, 4).reshape(B, L, H, Dh)
    lse = lse.reshape(B, dil, T, H).transpose(0, 2, 1, 3).reshape(B, L, H)
    return o, lse


def dilated_sample(q, kv_ext, window, dil, pos0):
    S = q.shape[1]
    back = window // dil
    idx = window + jnp.arange(S)[:, None] - dil * jnp.arange(back + 1)[None, :]
    kg = kv_ext[:, :, 0][:, idx]
    vg = kv_ext[:, :, 1][:, idx]
    s = jnp.einsum('bshd,bskhd->bhsk', q, kg, preferred_element_type=jnp.float32) * ATTN_SCALE
    valid = (pos0 - window + idx) >= 0
    s = jnp.where(valid[None, None], s, -jnp.inf)
    lse = jax.nn.logsumexp(s, axis=-1)
    p = jnp.exp(s - lse[..., None])
    o = jnp.einsum('bhsk,bskhd->bshd', p.astype(vg.dtype), vg)
    return o, lse.transpose(0, 2, 1)


def combine_by_denominator(outs, lses):
    wgt = jax.nn.softmax(jnp.stack(lses, axis=0).astype(jnp.float32), axis=0)
    return jnp.einsum('gblh,gblhd->blhd', wgt, jnp.stack(outs, axis=0).astype(jnp.float32))


def memory_kv(mem, mem_norm_g, w_mem_kv, mem_k_norm):
    B, M, _ = mem.shape
    kv = jnp.einsum('bmd,dc->bmc', rms_norm(mem, mem_norm_g), w_mem_kv).reshape(B, M, 2, MEM_HEADS, HEAD_DIM)
    k = rms_norm(kv[:, :, 0], mem_k_norm)
    return jnp.stack([k, kv[:, :, 1]], axis=2)


def mem_attention(q, kv):
    s = jnp.einsum('blhd,bmhd->bhlm', q, kv[:, :, 0], preferred_element_type=jnp.float32) * ATTN_SCALE
    p = jax.nn.softmax(s, axis=-1)
    return jnp.einsum('bhlm,bmhd->blhd', p.astype(q.dtype), kv[:, :, 1])


def mix_layer(x, pool_prev, dil_prev, mem_kv, pos0, norm_g, w_in, pool_w, pool_scale,
              dil_q_norm, dil_k_norm, mem_q_norm, w_out):
    B, L, _ = x.shape
    z = jnp.einsum('bld,dc->blc', rms_norm(x, norm_g), w_in)
    c0 = 2 * POOL_WIDTH
    c1 = c0 + 3 * N_DIL * DIL_WIDTH
    c2 = c1 + DIL_WIDTH
    c3 = c2 + MEM_WIDTH
    u = z[..., :POOL_WIDTH]
    gate_pool = z[..., POOL_WIDTH:c0]
    qkv = z[..., c0:c1].reshape(B, L, N_DIL, 3, DIL_HEADS, HEAD_DIM)
    gate_dil = z[..., c1:c2]
    q_mem = z[..., c2:c3].reshape(B, L, MEM_HEADS, HEAD_DIM)
    gate_mem = z[..., c3:]

    u_ext = jnp.concatenate([pool_prev.astype(u.dtype), u], axis=1)
    y_pool = pool_mix(u_ext, pos0, pool_w, pool_scale)
    new_pool = u_ext[:, -POOL_BUF:]

    outs, lses, new_dil = [], [], []
    for gi, (win, dil) in enumerate(DIL_PAIRS):
        q = rms_norm(qkv[:, :, gi, 0], dil_q_norm[gi])
        k = rms_norm(qkv[:, :, gi, 1], dil_k_norm[gi])
        v = qkv[:, :, gi, 2]
        kv = jnp.stack([k, v], axis=2)
        if dil_prev is None:
            o, lse = dilated_prompt(q, k, v, win, dil)
            kv_ext = kv if L >= win else jnp.pad(kv, ((0, 0), (win - L, 0), (0, 0), (0, 0), (0, 0)))
        else:
            kv_ext = jnp.concatenate([dil_prev[gi].astype(kv.dtype), kv], axis=1)
            o, lse = dilated_sample(q, kv_ext, win, dil, pos0)
        outs.append(o)
        lses.append(lse)
        new_dil.append(kv_ext[:, -win:])
    y_dil = combine_by_denominator(outs, lses).reshape(B, L, DIL_WIDTH).astype(x.dtype)

    q_mem = rms_norm(q_mem, mem_q_norm)
    y_mem = mem_attention(q_mem, mem_kv.astype(q_mem.dtype)).reshape(B, L, MEM_WIDTH)

    y = jnp.concatenate([jax.nn.silu(gate_pool) * y_pool,
                         jax.nn.silu(gate_dil) * y_dil,
                         jax.nn.silu(gate_mem) * y_mem], axis=-1)
    x = x + jnp.einsum('blc,cd->bld', y, w_out).astype(x.dtype)
    return x, new_pool, new_dil


def setup_inputs(seed: int = 0) -> dict:
    key = jax.random.key(seed)
    ks = jax.random.split(key, 24)
    f32 = jnp.float32

    def nrm(k, shape, scale=1.0):
        return jax.random.normal(k, shape, f32) * scale

    def gain(k, shape):
        return 1.0 + 0.02 * jax.random.normal(k, shape, f32)

    inp = {}
    inp['x_prompt'] = nrm(ks[0], (BATCH, SEQ, D_MODEL))
    inp['x_sample'] = nrm(ks[1], (DEC_BATCH, DEC_SEQ, D_MODEL))
    inp['state_pool'] = nrm(ks[2], (DEPTH, DEC_BATCH, POOL_BUF, POOL_WIDTH))
    inp['cache_dil_w128'] = nrm(ks[3], (DEPTH, DEC_BATCH, DIL_PAIRS[0][0], 2, DIL_HEADS, HEAD_DIM))
    inp['cache_dil_w512'] = nrm(ks[4], (DEPTH, DEC_BATCH, DIL_PAIRS[1][0], 2, DIL_HEADS, HEAD_DIM))
    inp['cache_dil_w2048'] = nrm(ks[5], (DEPTH, DEC_BATCH, DIL_PAIRS[2][0], 2, DIL_HEADS, HEAD_DIM))
    inp['cache_mem_kv'] = nrm(ks[6], (DEPTH, DEC_BATCH, MEM_LEN, 2, MEM_HEADS, HEAD_DIM))
    inp['mem_prompt'] = nrm(ks[7], (BATCH, MEM_LEN, D_MODEL))
    inp['norm_g'] = gain(ks[8], (DEPTH, D_MODEL))
    inp['w_in'] = nrm(ks[9], (DEPTH, D_MODEL, IN_COLS), D_MODEL ** -0.5)
    inp['pool_w'] = nrm(ks[10], (DEPTH, len(POOL_WINDOWS), POOL_GDIM, POOL_GDIM), POOL_GDIM ** -0.5)
    inp['pool_scale'] = gain(ks[11], (DEPTH, POOL_WIDTH))
    inp['dil_q_norm'] = gain(ks[12], (DEPTH, N_DIL, HEAD_DIM))
    inp['dil_k_norm'] = gain(ks[13], (DEPTH, N_DIL, HEAD_DIM))
    inp['mem_norm_g'] = gain(ks[14], (DEPTH, D_MODEL))
    inp['w_mem_kv'] = nrm(ks[15], (DEPTH, D_MODEL, 2 * MEM_WIDTH), D_MODEL ** -0.5)
    inp['mem_q_norm'] = gain(ks[16], (DEPTH, HEAD_DIM))
    inp['mem_k_norm'] = gain(ks[17], (DEPTH, HEAD_DIM))
    inp['w_out'] = nrm(ks[18], (DEPTH, MIX_WIDTH, D_MODEL), MIX_WIDTH ** -0.5)
    return inp


def reference(x_prompt, x_sample, state_pool, cache_dil_w128, cache_dil_w512, cache_dil_w2048,
              cache_mem_kv, mem_prompt, norm_g, w_in, pool_w, pool_scale, dil_q_norm, dil_k_norm,
              mem_norm_g, w_mem_kv, mem_q_norm, mem_k_norm, w_out):
    dil_caches = (cache_dil_w128, cache_dil_w512, cache_dil_w2048)
    y_prompt, y_sample = x_prompt, x_sample
    pool_p, pool_s, mem_p = [], [], []
    dil_p = [[] for _ in DIL_PAIRS]
    dil_s = [[] for _ in DIL_PAIRS]
    pool_zero = jnp.zeros((x_prompt.shape[0], POOL_BUF, POOL_WIDTH), x_prompt.dtype)
    for l in range(DEPTH):
        lw = (norm_g[l], w_in[l], pool_w[l], pool_scale[l], dil_q_norm[l], dil_k_norm[l],
              mem_q_norm[l], w_out[l])
        mem_kv_p = memory_kv(mem_prompt, mem_norm_g[l], w_mem_kv[l], mem_k_norm[l])
        y_prompt, np_l, nd_l = mix_layer(y_prompt, pool_zero, None, mem_kv_p, 0, *lw)
        y_sample, ns_l, nds_l = mix_layer(y_sample, state_pool[l], [c[l] for c in dil_caches],
                                          cache_mem_kv[l], PAST_LEN, *lw)
        pool_p.append(np_l)
        pool_s.append(ns_l)
        mem_p.append(mem_kv_p)
        for gi in range(N_DIL):
            dil_p[gi].append(nd_l[gi])
            dil_s[gi].append(nds_l[gi])
    state_pool_prompt = jnp.stack(pool_p)
    cache_dil_w128_prompt = jnp.stack(dil_p[0])
    cache_dil_w512_prompt = jnp.stack(dil_p[1])
    cache_dil_w2048_prompt = jnp.stack(dil_p[2])
    cache_mem_kv_prompt = jnp.stack(mem_p)
    state_pool_sample = jnp.stack(pool_s)
    cache_dil_w128_sample = jnp.stack(dil_s[0])
    cache_dil_w512_sample = jnp.stack(dil_s[1])
    cache_dil_w2048_sample = jnp.stack(dil_s[2])
    return (y_prompt, y_sample, state_pool_prompt, cache_dil_w128_prompt, cache_dil_w512_prompt,
            cache_dil_w2048_prompt, cache_mem_kv_prompt, state_pool_sample, cache_dil_w128_sample,
            cache_dil_w512_sample, cache_dil_w2048_sample)
```

```cpp
#include <hip/hip_runtime.h>
#include <hip/hip_cooperative_groups.h>
#include <cstdio>
#include <cstdint>
namespace cg = cooperative_groups;

#define LAS __attribute__((address_space(3)))
#define DI __device__ __forceinline__
typedef unsigned short bf16_t;
typedef short bf16x8 __attribute__((ext_vector_type(8)));
typedef short s16x4 __attribute__((ext_vector_type(4)));
typedef float f32x4 __attribute__((ext_vector_type(4)));
typedef unsigned u32x4 __attribute__((ext_vector_type(4)));
typedef unsigned u32x2 __attribute__((ext_vector_type(2)));

constexpr int DM = 2048, SEQ = 4096, NTOK = 8192, DEPTH = 4, SBATCH = 8, INC = 7168, MIXW = 1536;
constexpr int LDA = 2048 + 128;
constexpr int LDY = 1536 + 128;
constexpr int NMEM = 512;
constexpr float EPS = 1e-6f;
constexpr float ATTN_SCALE = 0.08838834764831845f;
constexpr int LDS_BYTES = 147456;
constexpr int NPHASE = 1 + 4 * DEPTH;

constexpr size_t O_YP = 0;
constexpr size_t O_YS = O_YP + (size_t)2 * 4096 * 2048;
constexpr size_t O_SPP = O_YS + (size_t)8 * 2048;
constexpr size_t O_C128P = O_SPP + (size_t)4 * 2 * 15 * 512;
constexpr size_t O_C512P = O_C128P + (size_t)4 * 2 * 128 * 1024;
constexpr size_t O_C2048P = O_C512P + (size_t)4 * 2 * 512 * 1024;
constexpr size_t O_MEMP = O_C2048P + (size_t)4 * 2 * 2048 * 1024;
constexpr size_t O_SPS = O_MEMP + (size_t)4 * 2 * 256 * 1024;
constexpr size_t O_C128S = O_SPS + (size_t)4 * 8 * 15 * 512;
constexpr size_t O_C512S = O_C128S + (size_t)4 * 8 * 128 * 1024;
constexpr size_t O_C2048S = O_C512S + (size_t)4 * 8 * 512 * 1024;

constexpr size_t W_WT = 0;
constexpr size_t W_WOT = W_WT + (size_t)4 * 8192 * LDA * 2;
constexpr size_t W_AALL = W_WOT + (size_t)4 * 2048 * LDY * 2;
constexpr size_t W_Z = W_AALL + (size_t)8704 * LDA * 2;
constexpr size_t W_ZMEM = W_Z + (size_t)8192 * 7168 * 2;
constexpr size_t W_Y = W_ZMEM + (size_t)512 * 1024 * 2;
constexpr size_t W_OG = W_Y + (size_t)8192 * LDY * 2;
constexpr size_t W_LSE = W_OG + (size_t)3 * 8192 * 512 * 2;
constexpr size_t W_SSQ = W_LSE + (size_t)3 * 8192 * 4 * 4;
constexpr size_t W_RMEM = W_SSQ + (size_t)8192 * 32 * 4;
constexpr size_t W_ZS = W_RMEM + 4096;
constexpr size_t W_YS = W_ZS + (size_t)8 * 7168 * 4;
constexpr size_t W_BAR = W_YS + (size_t)8 * 1536 * 4;
constexpr size_t W_END = W_BAR + 16384;

struct Params {
    const float *x_prompt, *x_sample, *state_pool, *c128, *c512, *c2048, *cmem, *mem_prompt, *norm_g, *w_in, *pool_w, *pool_scale,
        *dil_q_norm, *dil_k_norm, *mem_norm_g, *w_mem_kv, *mem_q_norm, *mem_k_norm, *w_out;
    float* out;
    unsigned char* ws;
};

DI unsigned short f2bf(float f) { unsigned u = __float_as_uint(f); u += 0x7fffu + ((u >> 16) & 1u); return (unsigned short)(u >> 16); }
typedef __bf16 hbf16x2 __attribute__((ext_vector_type(2)));
typedef float f32x2 __attribute__((ext_vector_type(2)));
DI unsigned pk2(float lo, float hi) { const f32x2 f = {lo, hi}; return __builtin_bit_cast(unsigned, __builtin_convertvector(f, hbf16x2)); }
DI float bf2f(unsigned short b) { return __uint_as_float(((unsigned)b) << 16); }
DI float bflo(unsigned u) { return __uint_as_float(u << 16); }
DI float bfhi(unsigned u) { return __uint_as_float(u & 0xffff0000u); }
DI float silu(float x) { return x / (1.f + __expf(-x)); }
DI float wave_sum(float v) {
#pragma unroll
    for (int o = 32; o >= 1; o >>= 1) v += __shfl_xor(v, o);
    return v;
}
DI float dpp_add(float v, const int ctrl_is) { return v; }
DI float row16_sum(float v) {
    v += __builtin_bit_cast(float, __builtin_amdgcn_update_dpp(0, __builtin_bit_cast(int, v), 0xB1, 0xF, 0xF, true));
    v += __builtin_bit_cast(float, __builtin_amdgcn_update_dpp(0, __builtin_bit_cast(int, v), 0x4E, 0xF, 0xF, true));
    v += __builtin_bit_cast(float, __builtin_amdgcn_update_dpp(0, __builtin_bit_cast(int, v), 0x141, 0xF, 0xF, true));
    v += __builtin_bit_cast(float, __builtin_amdgcn_update_dpp(0, __builtin_bit_cast(int, v), 0x140, 0xF, 0xF, true));
    return v;
}
DI float wave_max(float v) {
#pragma unroll
    for (int o = 32; o >= 1; o >>= 1) v = fmaxf(v, __shfl_xor(v, o));
    return v;
}
DI int opaque_tid() { int t = threadIdx.x; asm volatile("" : "+v"(t)); return t; }
DI f32x4 mfma16(bf16x8 a, bf16x8 b, f32x4 c) { return __builtin_amdgcn_mfma_f32_16x16x32_bf16(a, b, c, 0, 0, 0); }

namespace pg8 {
constexpr int BM = 256, BK = 64, HALF = 128, HTB = HALF * BK * 2, STAGE_BYTES = 8 * HTB, NXCD = 8, WGM = 8;
DI int lds_byte(int r, int c) { const int st = (r >> 4) * 2 + (c >> 5), rr = r & 15, cc = c & 31, ob = rr * 64 + cc * 2; return st * 1024 + (ob ^ (((ob >> 9) & 1) << 5)); }
DI void stage_rc(int b, int& R, int& C) { const int st = b / 1024, sb = b % 1024, swz = sb ^ (((sb >> 9) & 1) << 5); R = (st >> 1) * 16 + swz / 64; C = (st & 1) * 32 + (swz % 64) / 2; }
DI int perm32(int rho) { const int n = rho >> 4, i = rho & 15; return 8 * (i >> 2) + 4 * n + (i & 3); }
struct Unit { int pm, pn; };
struct Gemm { const bf16_t* A; const bf16_t* Bt; int K, ld; };

DI bool static_unit(int L, int nM, int nN, Unit& u) {
    const int nwg = nM * nN;
    int wgid = L; { const int q = nwg / NXCD, r = nwg % NXCD, xcd = wgid % NXCD, off = wgid / NXCD; wgid = (xcd < r ? xcd * (q + 1) : r * (q + 1) + (xcd - r) * q) + off; }
    const int nig = WGM * nN, gid = wgid / nig, fm = gid * WGM, gsz = (nM - fm) < WGM ? (nM - fm) : WGM;
    u.pm = fm + ((wgid % nig) % gsz); u.pn = (wgid % nig) / gsz; return true;
}

template <class Epi, class Sched, bool ALIGN_EPI, bool SP2>
DI void gemm_phase(LAS unsigned char* lds, const Gemm g, const Sched& S, const Epi& E) {
    const int tid = opaque_tid(), wid = __builtin_amdgcn_readfirstlane(tid >> 6), lane = tid & 63, wr = wid >> 2, wc = wid & 3, fr = lane & 15, fq = lane >> 4;
    const int K = g.K, nt = K / BK, ld = g.ld;
    unsigned voffA[2], voffB[2];
#pragma unroll
    for (int i = 0; i < 2; ++i) { int R, C; stage_rc(tid * 16 + i * 8192, R, C); const int Rb = (R & ~31) + perm32(R & 31);
        voffA[i] = (unsigned)(R * ld + C) * 2u; voffB[i] = (unsigned)(Rb * ld + C) * 2u; }
    const size_t kstep = (size_t)(BK * 2);
    const size_t hstep = (size_t)HALF * ld * 2;
    const size_t tstep = 2 * hstep;
    const unsigned ldsw = (unsigned)wid * 1024u;
    const int aoff = lds_byte(wr * 64 + fr, fq * 8), boff = lds_byte(wc * 32 + fr, fq * 8);
#define PG8_SA(b, h) (((b) * 2 + (h)) * HTB)
#define PG8_SB(b, h) ((4 + (b) * 2 + (h)) * HTB)
#define PG8_STAGE(bufoff, gbase, voff) do { _Pragma("unroll") for (int _i = 0; _i < 2; ++_i) \
        __builtin_amdgcn_global_load_lds((const unsigned*)((const char*)(gbase) + (voff)[_i]), (LAS unsigned*)(lds + (bufoff) + ldsw + _i * 8192), 16, 0, 0); } while (0)
#define PG8_LDA(dst, b, h) do { _Pragma("unroll") for (int m = 0; m < 4; ++m) _Pragma("unroll") for (int k = 0; k < 2; ++k) dst[m][k] = *(const LAS bf16x8*)(lds + PG8_SA(b, h) + aoff + m * 2048 + k * 1024); } while (0)
#define PG8_LDB(dst, b, h) do { _Pragma("unroll") for (int n = 0; n < 2; ++n) _Pragma("unroll") for (int k = 0; k < 2; ++k) dst[n][k] = *(const LAS bf16x8*)(lds + PG8_SB(b, h) + boff + n * 2048 + k * 1024); } while (0)
#define PG8_MMA(ai, bj, At, Bt) do { __builtin_amdgcn_s_setprio(1); _Pragma("unroll") for (int m = 0; m < 4; ++m) _Pragma("unroll") for (int n = 0; n < 2; ++n) _Pragma("unroll") for (int k = 0; k < 2; ++k) \
        acc[ai][bj][m][n] = __builtin_amdgcn_mfma_f32_16x16x32_bf16(Bt[n][k], At[m][k], acc[ai][bj][m][n], 0, 0, 0); __builtin_amdgcn_s_setprio(0); } while (0)
#define PG8_WAIT_V(n) asm volatile("s_waitcnt vmcnt(" #n ")" ::: "memory")
#define PG8_WAIT_L(n) asm volatile("s_waitcnt lgkmcnt(" #n ")" ::: "memory")
#define PG8_BAR __builtin_amdgcn_s_barrier()
#define PG8_SCHED __builtin_amdgcn_sched_barrier(0)
    Unit cur, nxt; int ui = 0;
    if (!S.next(0, cur)) return;
    f32x4 acc[2][2][4][2];
#pragma unroll
    for (int a = 0; a < 2; ++a)
#pragma unroll
        for (int b = 0; b < 2; ++b)
#pragma unroll
            for (int m = 0; m < 4; ++m)
#pragma unroll
                for (int n = 0; n < 2; ++n) acc[a][b][m][n] = (f32x4){0.f, 0.f, 0.f, 0.f};
    bf16x8 At[4][2], B0[2][2], B1[2][2];
    const char* cA = (const char*)g.A + (size_t)cur.pm * tstep; const char* cB = (const char*)g.Bt + (size_t)cur.pn * tstep;
    if constexpr (SP2) {
        PG8_STAGE(PG8_SB(0, 0), cB, voffB); PG8_STAGE(PG8_SB(0, 1), cB + hstep, voffB); PG8_STAGE(PG8_SA(0, 0), cA, voffA); PG8_STAGE(PG8_SA(0, 1), cA + hstep, voffA);
        if (wr == 1) PG8_BAR;
        PG8_WAIT_V(2); PG8_BAR;
        PG8_STAGE(PG8_SB(1, 0), cB + kstep, voffB); PG8_STAGE(PG8_SA(1, 0), cA + kstep, voffA); PG8_STAGE(PG8_SB(1, 1), cB + hstep + kstep, voffB);
        PG8_WAIT_V(6); PG8_BAR;
    } else {
        PG8_STAGE(PG8_SB(0, 0), cB, voffB); PG8_STAGE(PG8_SA(0, 0), cA, voffA); PG8_STAGE(PG8_SB(0, 1), cB + hstep, voffB); PG8_STAGE(PG8_SA(0, 1), cA + hstep, voffA);
        if (wr == 1) PG8_BAR;
        PG8_WAIT_V(4); PG8_BAR;
        PG8_STAGE(PG8_SB(1, 0), cB + kstep, voffB); PG8_STAGE(PG8_SA(1, 0), cA + kstep, voffA); PG8_STAGE(PG8_SB(1, 1), cB + hstep + kstep, voffB);
        PG8_WAIT_V(6); PG8_BAR;
    }
    for (;;) {
        const bool has_next = S.next(ui + 1, nxt);
        const char* nA = has_next ? (const char*)g.A + (size_t)nxt.pm * tstep : cA; const char* nB = has_next ? (const char*)g.Bt + (size_t)nxt.pn * tstep : cB;
        for (int t = 0; t < nt; t += 2) {
            const bool last = (t == nt - 2);
            const char* a1 = cA + (size_t)(t + 1) * kstep;
            const char* a2 = last ? nA : cA + (size_t)(t + 2) * kstep; const char* b2 = last ? nB : cB + (size_t)(t + 2) * kstep;
            const char* a3 = a2 + kstep; const char* b3 = b2 + kstep;
            if constexpr (SP2) {
            PG8_LDB(B0, 0, 0); PG8_LDB(B1, 0, 1); PG8_SCHED; PG8_LDA(At, 0, 0); PG8_STAGE(PG8_SA(1, 1), a1 + hstep, voffA);
            PG8_WAIT_V(8); PG8_WAIT_L(0); PG8_BAR; PG8_MMA(0, 0, At, B0); PG8_MMA(0, 1, At, B1); PG8_BAR; PG8_SCHED;
            PG8_LDA(At, 0, 1); PG8_STAGE(PG8_SB(0, 0), b2, voffB); PG8_STAGE(PG8_SB(0, 1), b2 + hstep, voffB); PG8_STAGE(PG8_SA(0, 0), a2, voffA);
            PG8_WAIT_V(8); PG8_WAIT_L(0); PG8_BAR; PG8_MMA(1, 0, At, B0); PG8_MMA(1, 1, At, B1); PG8_BAR; PG8_SCHED;
            PG8_LDB(B0, 1, 0); PG8_LDB(B1, 1, 1); PG8_SCHED; PG8_LDA(At, 1, 0); PG8_STAGE(PG8_SA(0, 1), a2 + hstep, voffA);
            PG8_WAIT_V(8); PG8_WAIT_L(0); PG8_BAR; PG8_MMA(0, 0, At, B0); PG8_MMA(0, 1, At, B1); PG8_BAR; PG8_SCHED;
            PG8_LDA(At, 1, 1); PG8_STAGE(PG8_SB(1, 0), b3, voffB); PG8_STAGE(PG8_SB(1, 1), b3 + hstep, voffB); PG8_STAGE(PG8_SA(1, 0), a3, voffA);
            PG8_WAIT_V(8); PG8_WAIT_L(0); PG8_BAR; PG8_MMA(1, 0, At, B0); PG8_MMA(1, 1, At, B1); PG8_BAR; PG8_SCHED;
            } else {
            PG8_LDB(B0, 0, 0); PG8_SCHED; PG8_LDA(At, 0, 0); PG8_STAGE(PG8_SA(1, 1), a1 + hstep, voffA);
            PG8_WAIT_L(8); PG8_BAR; PG8_WAIT_L(0); PG8_MMA(0, 0, At, B0); PG8_BAR; PG8_SCHED;
            PG8_LDB(B1, 0, 1); PG8_STAGE(PG8_SB(0, 0), b2, voffB);
            PG8_BAR; PG8_WAIT_L(0); PG8_MMA(0, 1, At, B1); PG8_BAR;
            PG8_LDA(At, 0, 1); PG8_STAGE(PG8_SA(0, 0), a2, voffA);
            PG8_BAR; PG8_WAIT_L(0); PG8_MMA(1, 0, At, B0); PG8_BAR; PG8_SCHED;
            PG8_STAGE(PG8_SB(0, 1), b2 + hstep, voffB);
            PG8_WAIT_V(6); PG8_BAR; PG8_MMA(1, 1, At, B1); PG8_BAR;
            PG8_LDB(B0, 1, 0); PG8_SCHED; PG8_LDA(At, 1, 0); PG8_STAGE(PG8_SA(0, 1), a2 + hstep, voffA);
            PG8_WAIT_L(8); PG8_BAR; PG8_WAIT_L(0); PG8_MMA(0, 0, At, B0); PG8_BAR; PG8_SCHED;
            PG8_LDB(B1, 1, 1); PG8_STAGE(PG8_SB(1, 0), b3, voffB);
            PG8_BAR; PG8_WAIT_L(0); PG8_MMA(0, 1, At, B1); PG8_BAR;
            PG8_LDA(At, 1, 1); PG8_STAGE(PG8_SA(1, 0), a3, voffA);
            PG8_BAR; PG8_WAIT_L(0); PG8_MMA(1, 0, At, B0); PG8_BAR; PG8_SCHED;
            PG8_STAGE(PG8_SB(1, 1), b3 + hstep, voffB);
            PG8_WAIT_V(6); PG8_BAR; PG8_MMA(1, 1, At, B1); PG8_BAR;
            }
        }
        if constexpr (ALIGN_EPI) { if (wr == 0) PG8_BAR; }
        E(acc, cur, ui, wr, wc, fr, fq);
        if (!has_next) break;
#pragma unroll
        for (int a = 0; a < 2; ++a)
#pragma unroll
            for (int b = 0; b < 2; ++b)
#pragma unroll
                for (int m = 0; m < 4; ++m)
#pragma unroll
                    for (int n = 0; n < 2; ++n) acc[a][b][m][n] = (f32x4){0.f, 0.f, 0.f, 0.f};
        cur = nxt; cA = nA; cB = nB; ++ui;
        if constexpr (ALIGN_EPI) { if (wr == 1) PG8_BAR; }
    }
    PG8_WAIT_V(0);
    if constexpr (!ALIGN_EPI) { if (wr == 0) PG8_BAR; }
    PG8_BAR;
#undef PG8_SA
#undef PG8_SB
#undef PG8_STAGE
#undef PG8_LDA
#undef PG8_LDB
#undef PG8_MMA
#undef PG8_WAIT_V
#undef PG8_WAIT_L
#undef PG8_BAR
#undef PG8_SCHED
}
}

constexpr bool GEMM_SP2 = true, GEMM_ALIGN = true;
struct SchedIn {
    int G, c;
    DI bool next(int i, pg8::Unit& u) const {
        const int L = i * G + c;
        if (L >= 904) return false;
        if (L >= 896) { const int e = L - 896; u.pm = 32 + (e >> 2); u.pn = 28 + (e & 3); return true; }
        return pg8::static_unit(L, 32, 28, u);
    }
};
struct SchedOut {
    int G, c;
    DI bool next(int i, pg8::Unit& u) const {
        const int L = i * G + c;
        if (L >= 256) return false;
        return pg8::static_unit(L, 32, 8, u);
    }
};
struct EpiIn {
    bf16_t* z; bf16_t* zmem; const LAS float* rtab;
    DI void operator()(const f32x4 (&acc)[2][2][4][2], const pg8::Unit& u, int ui, int wr, int wc, int fr, int fq) const {
        const bool ismem = u.pm >= 32;
        const int row0 = u.pm * 256 + wr * 64 + fr;
        const int colt = (ismem ? (u.pn - 28) : u.pn) * 256 + wc * 32 + 8 * fq;
        const int ldc = ismem ? 1024 : INC;
        bf16_t* base = ismem ? zmem - (size_t)8192 * 1024 : z;
#pragma unroll
        for (int ai = 0; ai < 2; ++ai)
#pragma unroll
            for (int m = 0; m < 4; ++m) {
                const int row = row0 + ai * 128 + m * 16;
                const float r = rtab[ui * 256 + wr * 64 + fr + ai * 128 + m * 16];
                bf16_t* rowp = base + (size_t)row * ldc + colt;
#pragma unroll
                for (int bj = 0; bj < 2; ++bj) { const f32x4 v0 = acc[ai][bj][m][0] * r, v1 = acc[ai][bj][m][1] * r;
                    u32x4 o; o[0] = pk2(v0[0], v0[1]); o[1] = pk2(v0[2], v0[3]); o[2] = pk2(v1[0], v1[1]); o[3] = pk2(v1[2], v1[3]);
                    *(u32x4*)(rowp + bj * 128) = o; }
            }
    }
};
struct EpiOut {
    const float* xin;
    float* yout;
    bf16_t* xb; LAS float* ssl;
    DI void operator()(const f32x4 (&acc)[2][2][4][2], const pg8::Unit& u, int ui, int wr, int wc, int fr, int fq) const {
        const int row0 = u.pm * 256 + wr * 64 + fr, col0 = u.pn * 256 + wc * 32 + 8 * fq;
#pragma unroll
        for (int ah = 0; ah < 4; ++ah) {
            const int ai = ah >> 1, mh = ah & 1;
            f32x4 xo[8];
            if (xin) {
#pragma unroll
                for (int mm = 0; mm < 2; ++mm)
#pragma unroll
                    for (int bj = 0; bj < 2; ++bj) { const size_t o = (size_t)(row0 + ai * 128 + (2 * mh + mm) * 16) * DM + col0 + bj * 128;
                        xo[(mm * 2 + bj) * 2] = __builtin_nontemporal_load((const f32x4*)(xin + o)); xo[(mm * 2 + bj) * 2 + 1] = __builtin_nontemporal_load((const f32x4*)(xin + o + 4)); }
                asm volatile("" : "+v"(xo[0]), "+v"(xo[1]), "+v"(xo[2]), "+v"(xo[3]), "+v"(xo[4]), "+v"(xo[5]), "+v"(xo[6]), "+v"(xo[7]));
            } else {
                u32x4 xq[4];
#pragma unroll
                for (int mm = 0; mm < 2; ++mm)
#pragma unroll
                    for (int bj = 0; bj < 2; ++bj) xq[mm * 2 + bj] = *(const u32x4*)(xb + (size_t)(row0 + ai * 128 + (2 * mh + mm) * 16) * LDA + col0 + bj * 128);
                asm volatile("" : "+v"(xq[0]), "+v"(xq[1]), "+v"(xq[2]), "+v"(xq[3]));
#pragma unroll
                for (int q = 0; q < 4; ++q) { xo[2 * q] = (f32x4){bflo(xq[q][0]), bfhi(xq[q][0]), bflo(xq[q][1]), bfhi(xq[q][1])}; xo[2 * q + 1] = (f32x4){bflo(xq[q][2]), bfhi(xq[q][2]), bflo(xq[q][3]), bfhi(xq[q][3])}; }
            }
#pragma unroll
            for (int mm = 0; mm < 2; ++mm) {
                const int m = 2 * mh + mm, row = row0 + ai * 128 + m * 16; float ss = 0.f;
#pragma unroll
                for (int bj = 0; bj < 2; ++bj) {
                    const f32x4 v0 = acc[ai][bj][m][0] + xo[(mm * 2 + bj) * 2], v1 = acc[ai][bj][m][1] + xo[(mm * 2 + bj) * 2 + 1];
                    if (yout) { const size_t o = (size_t)row * DM + col0 + bj * 128;
                        __builtin_nontemporal_store(v0, (f32x4*)(yout + o)); __builtin_nontemporal_store(v1, (f32x4*)(yout + o + 4)); }
                    else { u32x4 pb; pb[0] = pk2(v0[0], v0[1]); pb[1] = pk2(v0[2], v0[3]); pb[2] = pk2(v1[0], v1[1]); pb[3] = pk2(v1[2], v1[3]);
                        *(u32x4*)(xb + (size_t)row * LDA + col0 + bj * 128) = pb; }
                    ss += v0[0] * v0[0] + v0[1] * v0[1] + v0[2] * v0[2] + v0[3] * v0[3] + v1[0] * v1[0] + v1[1] * v1[1] + v1[2] * v1[2] + v1[3] * v1[3]; }
                ss += __shfl_xor(ss, 16); ss += __shfl_xor(ss, 32);
                if (fq == 0) ssl[(ai * 128 + wr * 64 + m * 16 + fr) * 4 + wc] = ss;
            }
        }
    }
};

constexpr int NCOPY_TAIL = 2688;
DI void cache_copy_layer(const Params& p, int l, int first, int stride, int lo, int hi) {
    const int tid = opaque_tid();
    if (lo + first >= hi) return;
    for (int u0 = lo + first; u0 < hi; u0 += 4 * stride) {
        f32x4 v[16]; f32x4* dp[4]; int idx[4][4];
#pragma unroll
        for (int hf = 0; hf < 4; ++hf) {
            const int uu = u0 + hf * stride, u = uu < hi ? uu : u0;
            const int b = u / 336, e = u % 336; int W, c; const float* src; float* dst;
            if (e < 16) { W = 128; c = e; src = p.c128; dst = p.out + O_C128S; }
            else if (e < 80) { W = 512; c = e - 16; src = p.c512; dst = p.out + O_C512S; }
            else { W = 2048; c = e - 80; src = p.c2048; dst = p.out + O_C2048S; }
            const size_t base = (size_t)(l * 8 + b) * W * 1024 + (size_t)c * 8192;
            const int n4 = min(8192, (W - 1) * 1024 - c * 8192) >> 2;
            const f32x4* s4 = (const f32x4*)(src + base + 1024); dp[hf] = (f32x4*)(dst + base);
#pragma unroll
            for (int k = 0; k < 4; ++k) { idx[hf][k] = min(tid + k * 512, n4 - 1); v[hf * 4 + k] = __builtin_nontemporal_load(s4 + idx[hf][k]); }
        }
#pragma unroll
        for (int hf = 0; hf < 4; ++hf)
#pragma unroll
            for (int k = 0; k < 4; ++k) __builtin_nontemporal_store(v[hf * 4 + k], dp[hf] + idx[hf][k]);
    }
}

DI void transpose_tile_w(const float* src, int ldn, const float* gain, bf16_t* dst, int ldk, int k0, int n0, LAS float* tile  , int lane, bool stream) {
    f32x4 v[16]; float gg[16];
    const int c4 = (lane & 15) * 4, rr = lane >> 4;
#pragma unroll
    for (int it = 0; it < 16; ++it) v[it] = __builtin_nontemporal_load((const f32x4*)(src + (size_t)(k0 + it * 4 + rr) * ldn + n0 + c4));
#pragma unroll
    for (int it = 0; it < 16; ++it) gg[it] = 1.f;
    if (gain) {
#pragma unroll
        for (int it = 0; it < 16; ++it) gg[it] = gain[k0 + it * 4 + rr]; }
#pragma unroll
    for (int it = 0; it < 16; ++it) { const int r = it * 4 + rr;
        tile[r * 65 + c4 + 0] = v[it][0] * gg[it]; tile[r * 65 + c4 + 1] = v[it][1] * gg[it]; tile[r * 65 + c4 + 2] = v[it][2] * gg[it]; tile[r * 65 + c4 + 3] = v[it][3] * gg[it]; }
#pragma unroll
    for (int it = 0; it < 8; ++it) { const int n = it * 8 + (lane >> 3), kc = (lane & 7) * 8; float t[8];
#pragma unroll
        for (int e = 0; e < 8; ++e) t[e] = tile[(kc + e) * 65 + n];
        u32x4 o; o[0] = pk2(t[0], t[1]); o[1] = pk2(t[2], t[3]); o[2] = pk2(t[4], t[5]); o[3] = pk2(t[6], t[7]);
        u32x4* dp = (u32x4*)(dst + (size_t)(n0 + n) * ldk + k0 + kc);
        if (stream) __builtin_nontemporal_store(o, dp); else *dp = o; }
}

constexpr int NTR_TAIL = 4864;
DI void transpose_layer(const Params& p, int l, int lo, int hi, int w0, int nw, LAS unsigned char* lds, int wid, int lane, bool stream) {
    bf16_t* WT = (bf16_t*)(p.ws + W_WT); bf16_t* WOT = (bf16_t*)(p.ws + W_WOT);
    LAS float* tile = (LAS float*)lds + wid * (64 * 65);
    for (int r = lo + w0; r < hi; r += nw) {
        if (r < 3584) { const int kt = r / 112, nt = r % 112;
            transpose_tile_w(p.w_in + (size_t)l * DM * INC, INC, p.norm_g + l * DM, WT + (size_t)l * 8192 * LDA, LDA, kt * 64, nt * 64, tile, lane, stream); }
        else if (r < 4096) { const int e = r - 3584, kt = e / 16, nt = e % 16;
            transpose_tile_w(p.w_mem_kv + (size_t)l * DM * 1024, 1024, p.mem_norm_g + l * DM, WT + (size_t)l * 8192 * LDA + (size_t)7168 * LDA, LDA, kt * 64, nt * 64, tile, lane, stream); }
        else { const int e = r - 4096, kt = e / 32, nt = e % 32;
            transpose_tile_w(p.w_out + (size_t)l * MIXW * DM, DM, nullptr, WOT + (size_t)l * 2048 * LDY, LDY, kt * 64, nt * 64, tile, lane, stream); }
    }
}

DI void prep_phase(const Params& p, LAS unsigned char* lds) {
    const int tid = opaque_tid(), wid = __builtin_amdgcn_readfirstlane(tid >> 6), lane = tid & 63, bid = blockIdx.x, G = gridDim.x;
    bf16_t* WT = (bf16_t*)(p.ws + W_WT); bf16_t* WOT = (bf16_t*)(p.ws + W_WOT); bf16_t* AALL = (bf16_t*)(p.ws + W_AALL);
    float* SSQ = (float*)(p.ws + W_SSQ); float* RMEM = (float*)(p.ws + W_RMEM);
    for (int row = bid * 8 + wid; row < NTOK + NMEM; row += G * 8) {
        const float* src = row < NTOK ? p.x_prompt + (size_t)row * DM : p.mem_prompt + (size_t)(row - NTOK) * DM;
        bf16_t* dst = AALL + (size_t)row * LDA; float ss = 0.f; f32x4 xv[8];
#pragma unroll
        for (int it = 0; it < 8; ++it) xv[it] = __builtin_nontemporal_load((const f32x4*)(src + it * 256 + lane * 4));
#pragma unroll
        for (int it = 0; it < 8; ++it) { const f32x4 v = xv[it];
            ss += v[0] * v[0] + v[1] * v[1] + v[2] * v[2] + v[3] * v[3];
            u32x2 o; o[0] = pk2(v[0], v[1]); o[1] = pk2(v[2], v[3]); *(u32x2*)(dst + it * 256 + lane * 4) = o; }
        ss = wave_sum(ss);
        if (row < NTOK) { if (lane < 8) SSQ[(size_t)row * 8 + lane] = lane == 0 ? ss : 0.f; }
        else if (lane == 0) RMEM[row - NTOK] = rsqrtf(ss * (1.f / 2048.f) + EPS);
    }
    transpose_layer(p, 0, 0, 4864, bid * 8 + wid, G * 8, lds, wid, lane, false);
    for (int l = 1; l < DEPTH; ++l) transpose_layer(p, l, NTR_TAIL, 4864, bid * 8 + wid, G * 8, lds, wid, lane, true);
    __syncthreads();
    for (int l = 0; l < DEPTH; ++l) cache_copy_layer(p, l, bid, G, NCOPY_TAIL, 2688);
}

constexpr int KSTR = 272;
constexpr int LDS_K = 0, LDS_V = 256 * KSTR;

DI void tr_read8(unsigned addr, s16x4 (&lo)[4], s16x4 (&hi)[4], int) {}

struct AttnItem {
    const bf16_t* qb; long qstep;
    const bf16_t* kb; long kstep;
    const float* qgain; const float* kgain;
    int kzero;
    int band;
    float* cache; long cstep; int cache_lo;
    bf16_t* og; long ogstep;
    float* lse; long lsestep;
    bf16_t* y; const bf16_t* gate;
};

DI void attn_item(const AttnItem& a, LAS unsigned char* lds) {
    const int tid = opaque_tid(), wid = __builtin_amdgcn_readfirstlane(tid >> 6), lane = tid & 63;
    const unsigned lbase = (unsigned)(uintptr_t)lds;
    const int qi = lane & 15, kq = lane >> 4;
    u32x4 qraw[4];
    {   const bf16_t* qp = a.qb + (long)(16 * wid + qi) * a.qstep + 8 * kq;
#pragma unroll
        for (int ks = 0; ks < 4; ++ks) qraw[ks] = __builtin_nontemporal_load((const u32x4*)(qp + 32 * ks)); }
    {   const int sub = lane & 15; float kg[8];
#pragma unroll
        for (int e = 0; e < 8; ++e) kg[e] = a.kgain[sub * 8 + e];
        u32x4 kraw[8], vraw[8];
#pragma unroll
        for (int it = 0; it < 8; ++it) {
            const int kk = it * 32 + wid * 4 + (lane >> 4);
            kraw[it] = (u32x4){0u, 0u, 0u, 0u}; vraw[it] = (u32x4){0u, 0u, 0u, 0u};
            if (!(a.kzero && it < 4)) { const bf16_t* kp = a.kb + (long)kk * a.kstep + sub * 8; kraw[it] = *(const u32x4*)kp; vraw[it] = *(const u32x4*)(kp + 512); }
        }
#pragma unroll
        for (int it = 0; it < 8; ++it) {
            const int kk = it * 32 + wid * 4 + (lane >> 4);
            float kf[8]; float ss = 0.f;
#pragma unroll
            for (int e = 0; e < 4; ++e) { kf[2 * e] = bflo(kraw[it][e]); kf[2 * e + 1] = bfhi(kraw[it][e]); ss += kf[2 * e] * kf[2 * e] + kf[2 * e + 1] * kf[2 * e + 1]; }
            ss = row16_sum(ss);
            const float rs = rsqrtf(ss * (1.f / 128.f) + EPS);
#pragma unroll
            for (int e = 0; e < 8; ++e) kf[e] *= rs * kg[e];
            u32x4 kn; kn[0] = pk2(kf[0], kf[1]); kn[1] = pk2(kf[2], kf[3]); kn[2] = pk2(kf[4], kf[5]); kn[3] = pk2(kf[6], kf[7]);
            *(LAS u32x4*)(lds + LDS_K + kk * KSTR + sub * 16) = kn;
            *(LAS u32x4*)(lds + LDS_V + kk * KSTR + sub * 16) = vraw[it];
            if (a.cache && kk >= a.cache_lo) {
                float* cp = a.cache + (long)(kk - a.cache_lo) * a.cstep + sub * 8;
                __builtin_nontemporal_store((f32x4){kf[0], kf[1], kf[2], kf[3]}, (f32x4*)cp); __builtin_nontemporal_store((f32x4){kf[4], kf[5], kf[6], kf[7]}, (f32x4*)(cp + 4));
                __builtin_nontemporal_store((f32x4){bflo(vraw[it][0]), bfhi(vraw[it][0]), bflo(vraw[it][1]), bfhi(vraw[it][1])}, (f32x4*)(cp + 512));
                __builtin_nontemporal_store((f32x4){bflo(vraw[it][2]), bfhi(vraw[it][2]), bflo(vraw[it][3]), bfhi(vraw[it][3])}, (f32x4*)(cp + 516));
            }
        }
    }
    bf16x8 qf[4];
    {   float ss = 0.f;
#pragma unroll
        for (int ks = 0; ks < 4; ++ks) {
#pragma unroll
            for (int e = 0; e < 4; ++e) { const float lo = bflo(qraw[ks][e]), hi = bfhi(qraw[ks][e]); ss += lo * lo + hi * hi; } }
        ss += __shfl_xor(ss, 16); ss += __shfl_xor(ss, 32);
        const float rs = rsqrtf(ss * (1.f / 128.f) + EPS) * (ATTN_SCALE * 1.4426950408889634f);
#pragma unroll
        for (int ks = 0; ks < 4; ++ks) { const f32x4 g0 = *(const f32x4*)(a.qgain + 32 * ks + 8 * kq), g1 = *(const f32x4*)(a.qgain + 32 * ks + 8 * kq + 4);
            u32x4 o; o[0] = pk2(bflo(qraw[ks][0]) * rs * g0[0], bfhi(qraw[ks][0]) * rs * g0[1]); o[1] = pk2(bflo(qraw[ks][1]) * rs * g0[2], bfhi(qraw[ks][1]) * rs * g0[3]);
            o[2] = pk2(bflo(qraw[ks][2]) * rs * g1[0], bfhi(qraw[ks][2]) * rs * g1[1]); o[3] = pk2(bflo(qraw[ks][3]) * rs * g1[2], bfhi(qraw[ks][3]) * rs * g1[3]);
            qf[ks] = __builtin_bit_cast(bf16x8, o); }
    }
    __syncthreads();
    const int kp0 = a.band ? (wid >> 1) : 0;
    const int kpa = (a.band && a.kzero && kp0 < 4) ? 4 : kp0, kp1 = a.band ? kp0 + 5 : 8;
    f32x4 sacc[16];
#pragma unroll
    for (int kp = 0; kp < 8; ++kp)
#pragma unroll
        for (int t = 0; t < 2; ++t) {
            const int krow = 32 * kp + 8 * (qi >> 2) + 4 * t + (qi & 3);
            f32x4 acc = (f32x4){0.f, 0.f, 0.f, 0.f};
            if (kp >= kpa && kp < kp1)
#pragma unroll
            for (int ks = 0; ks < 4; ++ks) { const bf16x8 kf = *(const LAS bf16x8*)(lds + LDS_K + krow * KSTR + (32 * ks + 8 * kq) * 2); acc = mfma16(kf, qf[ks], acc); }
            sacc[2 * kp + t] = acc;
            __builtin_amdgcn_sched_barrier(0);
        }
    const int iq = 16 * wid + qi;
    float m = -INFINITY;
#pragma unroll
    for (int kp = 0; kp < 8; ++kp)
        if (kp >= kpa && kp < kp1) {
            if (a.band && (kp == kp0 || kp == kp0 + 4)) {
#pragma unroll
                for (int t = 0; t < 2; ++t)
#pragma unroll
                    for (int j = 0; j < 4; ++j) { const int kk = 32 * kp + 8 * kq + 4 * t + j; const int dist = 128 + iq - kk;
                        if (!(dist >= 0 && dist <= 128)) sacc[2 * kp + t][j] = -INFINITY; }
            }
#pragma unroll
            for (int t = 0; t < 2; ++t) m = fmaxf(m, fmaxf(fmaxf(sacc[2 * kp + t][0], sacc[2 * kp + t][1]), fmaxf(sacc[2 * kp + t][2], sacc[2 * kp + t][3])));
        }
    m = fmaxf(m, __shfl_xor(m, 16)); m = fmaxf(m, __shfl_xor(m, 32));
    float sum = 0.f; bf16x8 pb[8];
#pragma unroll
    for (int kp = 0; kp < 8; ++kp) {
        pb[kp] = (bf16x8){0, 0, 0, 0, 0, 0, 0, 0};
        if (kp >= kpa && kp < kp1) { float pv[8];
#pragma unroll
            for (int t = 0; t < 2; ++t)
#pragma unroll
                for (int j = 0; j < 4; ++j) { const float pe = __builtin_amdgcn_exp2f(sacc[2 * kp + t][j] - m); pv[4 * t + j] = pe; sum += pe; }
            u32x4 o; o[0] = pk2(pv[0], pv[1]); o[1] = pk2(pv[2], pv[3]); o[2] = pk2(pv[4], pv[5]); o[3] = pk2(pv[6], pv[7]);
            pb[kp] = __builtin_bit_cast(bf16x8, o); } }
    sum += __shfl_xor(sum, 16); sum += __shfl_xor(sum, 32);
    f32x4 oacc[8];
#pragma unroll
    for (int dt = 0; dt < 8; ++dt) oacc[dt] = (f32x4){0.f, 0.f, 0.f, 0.f};
    const unsigned vaddr0 = lbase + LDS_V + (8 * kq + ((lane & 15) >> 2)) * KSTR + (lane & 3) * 8;
#pragma unroll
    for (int kp = 0; kp < 8; ++kp) {
        const unsigned va = vaddr0 + kp * 32 * KSTR;
        if (kp >= kpa && kp < kp1)
#pragma unroll
        for (int hf = 0; hf < 2; ++hf) {
            s16x4 r0, r1, r2, r3, r4, r5, r6, r7;
            asm volatile("ds_read_b64_tr_b16 %0, %8\n\tds_read_b64_tr_b16 %1, %8 offset:1088\n\t"
                         "ds_read_b64_tr_b16 %2, %8 offset:32\n\tds_read_b64_tr_b16 %3, %8 offset:1120\n\t"
                         "ds_read_b64_tr_b16 %4, %8 offset:64\n\tds_read_b64_tr_b16 %5, %8 offset:1152\n\t"
                         "ds_read_b64_tr_b16 %6, %8 offset:96\n\tds_read_b64_tr_b16 %7, %8 offset:1184\n\ts_waitcnt lgkmcnt(0)"
                         : "=&v"(r0), "=&v"(r1), "=&v"(r2), "=&v"(r3), "=&v"(r4), "=&v"(r5), "=&v"(r6), "=&v"(r7) : "v"(va + hf * 128) : "memory");
            bf16x8 a0 = __builtin_shufflevector(r0, r1, 0, 1, 2, 3, 4, 5, 6, 7), a1 = __builtin_shufflevector(r2, r3, 0, 1, 2, 3, 4, 5, 6, 7);
            bf16x8 a2 = __builtin_shufflevector(r4, r5, 0, 1, 2, 3, 4, 5, 6, 7), a3 = __builtin_shufflevector(r6, r7, 0, 1, 2, 3, 4, 5, 6, 7);
            oacc[4 * hf + 0] = mfma16(a0, pb[kp], oacc[4 * hf + 0]); oacc[4 * hf + 1] = mfma16(a1, pb[kp], oacc[4 * hf + 1]);
            oacc[4 * hf + 2] = mfma16(a2, pb[kp], oacc[4 * hf + 2]); oacc[4 * hf + 3] = mfma16(a3, pb[kp], oacc[4 * hf + 3]);
            __builtin_amdgcn_sched_barrier(0);
        }
    }
    const float inv = 1.f / sum;
    __syncthreads();
    {   LAS unsigned char* ob = lds + LDS_K;
#pragma unroll
        for (int dt = 0; dt < 8; ++dt) { u32x2 o; o[0] = pk2(oacc[dt][0] * inv, oacc[dt][1] * inv); o[1] = pk2(oacc[dt][2] * inv, oacc[dt][3] * inv);
            *(LAS u32x2*)(ob + iq * KSTR + (16 * dt + 4 * kq) * 2) = o; }
        const int ch = lane & 15, rsub = lane >> 4;
        if (a.band) {
#pragma unroll
            for (int it = 0; it < 4; ++it) { const int row = 16 * wid + 4 * it + rsub; const u32x4 v = *(const LAS u32x4*)(ob + row * KSTR + ch * 16);
                *(u32x4*)(a.og + (long)row * a.ogstep + 8 * ch) = v; }
            if (kq == 0) a.lse[(long)iq * a.lsestep] = (m + __log2f(sum)) * 0.6931471805599453f;
        } else {
            u32x4 gv[4];
#pragma unroll
            for (int it = 0; it < 4; ++it) gv[it] = __builtin_nontemporal_load((const u32x4*)(a.gate + (long)(16 * wid + 4 * it + rsub) * INC + 8 * ch));
            asm volatile("" : "+v"(gv[0]), "+v"(gv[1]), "+v"(gv[2]), "+v"(gv[3]));
#pragma unroll
            for (int it = 0; it < 4; ++it) { const int row = 16 * wid + 4 * it + rsub; const u32x4 v = *(const LAS u32x4*)(ob + row * KSTR + ch * 16);
                u32x4 o;
#pragma unroll
                for (int e = 0; e < 4; ++e) o[e] = pk2(silu(bflo(gv[it][e])) * bflo(v[e]), silu(bfhi(gv[it][e])) * bfhi(v[e]));
                *(u32x4*)(a.y + (long)row * LDY + 8 * ch) = o; }
        }
    }
    __syncthreads();
}

constexpr int LDS_PU = 0, LDS_PW = 143 * 128 * 4, LDS_PD = LDS_PW + 128 * KSTR;
DI void pool_item(const Params& p, int l, int tt, int gi, LAS unsigned char* lds) {
    const int tid = opaque_tid(), wid = __builtin_amdgcn_readfirstlane(tid >> 6), lane = tid & 63;
    const unsigned lbase = (unsigned)(uintptr_t)lds;
    const bf16_t* Z = (const bf16_t*)(p.ws + W_Z); bf16_t* Y = (bf16_t*)(p.ws + W_Y);
    const int t0 = tt * 128, pos0 = t0 & (SEQ - 1), b = t0 >> 12, w = 2 << gi;
    LAS float* U = (LAS float*)(lds + LDS_PU);
    {   u32x4 raw[5]; const int sub = lane & 15;
#pragma unroll
        for (int it = 0; it < 5; ++it) { const int row = it * 32 + wid * 4 + (lane >> 4); raw[it] = (u32x4){0u, 0u, 0u, 0u};
            if (row < 143 && pos0 + row - 15 >= 0) raw[it] = *(const u32x4*)(Z + (size_t)(t0 + row - 15) * INC + gi * 128 + sub * 8); }
#pragma unroll
        for (int it = 0; it < 5; ++it) { const int row = it * 32 + wid * 4 + (lane >> 4);
            if (row < 143) { LAS float* up = U + row * 128 + sub * 8;
                *(LAS f32x4*)up = (f32x4){bflo(raw[it][0]), bfhi(raw[it][0]), bflo(raw[it][1]), bfhi(raw[it][1])}; *(LAS f32x4*)(up + 4) = (f32x4){bflo(raw[it][2]), bfhi(raw[it][2]), bflo(raw[it][3]), bfhi(raw[it][3])}; } }
    }
    {   const float* wsrc = p.pool_w + ((size_t)l * 4 + gi) * 16384;
#pragma unroll
        for (int it = 0; it < 4; ++it) { const int idx = it * 512 + tid, c = idx >> 4, ch = idx & 15; const f32x4 v0 = *(const f32x4*)(wsrc + c * 128 + ch * 8), v1 = *(const f32x4*)(wsrc + c * 128 + ch * 8 + 4);
            u32x4 o; o[0] = pk2(v0[0], v0[1]); o[1] = pk2(v0[2], v0[3]); o[2] = pk2(v1[0], v1[1]); o[3] = pk2(v1[2], v1[3]);
            *(LAS u32x4*)(lds + LDS_PW + c * KSTR + ch * 16) = o; } }
    __syncthreads();
    {   const int c4 = (tid & 31) * 4, rg = tid >> 5;
        for (int k = 0; k < 8; ++k) { const int t = rg * 8 + k; f32x4 s = (f32x4){0.f, 0.f, 0.f, 0.f};
            for (int i = 0; i < w; ++i) s += *(const LAS f32x4*)(U + (15 + t - i) * 128 + c4);
            const float ic = 1.f / (float)min(w, pos0 + t + 1); const f32x4 un = *(const LAS f32x4*)(U + (15 + t) * 128 + c4);
            u32x2 o; o[0] = pk2(s[0] * ic - un[0], s[1] * ic - un[1]); o[1] = pk2(s[2] * ic - un[2], s[3] * ic - un[3]);
            *(LAS u32x2*)(lds + LDS_PD + t * KSTR + c4 * 2) = o; }
        if (pos0 == SEQ - 128) { float* sp = p.out + O_SPP + ((size_t)(l * 2 + b) * 15) * 512 + gi * 128;
            for (int e = tid; e < 15 * 128; e += 512) { const int i = e >> 7, c = e & 127; sp[i * 512 + c] = U[(128 + i) * 128 + c]; } }
    }
    __syncthreads();
    const int qi = lane & 15, kq = lane >> 4;
    f32x4 acc[8];
#pragma unroll
    for (int nt = 0; nt < 8; ++nt) acc[nt] = (f32x4){0.f, 0.f, 0.f, 0.f};
    const unsigned waddr0 = lbase + LDS_PW + (8 * kq + ((lane & 15) >> 2)) * KSTR + (lane & 3) * 8;
#pragma unroll
    for (int ks = 0; ks < 4; ++ks) {
        const bf16x8 df = *(const LAS bf16x8*)(lds + LDS_PD + (16 * wid + qi) * KSTR + (32 * ks + 8 * kq) * 2);
        const unsigned va = waddr0 + ks * 32 * KSTR;
#pragma unroll
        for (int hf = 0; hf < 2; ++hf) {
            s16x4 r0, r1, r2, r3, r4, r5, r6, r7;
            asm volatile("ds_read_b64_tr_b16 %0, %8\n\tds_read_b64_tr_b16 %1, %8 offset:1088\n\t"
                         "ds_read_b64_tr_b16 %2, %8 offset:32\n\tds_read_b64_tr_b16 %3, %8 offset:1120\n\t"
                         "ds_read_b64_tr_b16 %4, %8 offset:64\n\tds_read_b64_tr_b16 %5, %8 offset:1152\n\t"
                         "ds_read_b64_tr_b16 %6, %8 offset:96\n\tds_read_b64_tr_b16 %7, %8 offset:1184\n\ts_waitcnt lgkmcnt(0)"
                         : "=&v"(r0), "=&v"(r1), "=&v"(r2), "=&v"(r3), "=&v"(r4), "=&v"(r5), "=&v"(r6), "=&v"(r7) : "v"(va + hf * 128) : "memory");
            bf16x8 a0 = __builtin_shufflevector(r0, r1, 0, 1, 2, 3, 4, 5, 6, 7), a1 = __builtin_shufflevector(r2, r3, 0, 1, 2, 3, 4, 5, 6, 7);
            bf16x8 a2 = __builtin_shufflevector(r4, r5, 0, 1, 2, 3, 4, 5, 6, 7), a3 = __builtin_shufflevector(r6, r7, 0, 1, 2, 3, 4, 5, 6, 7);
            acc[4 * hf + 0] = mfma16(a0, df, acc[4 * hf + 0]); acc[4 * hf + 1] = mfma16(a1, df, acc[4 * hf + 1]);
            acc[4 * hf + 2] = mfma16(a2, df, acc[4 * hf + 2]); acc[4 * hf + 3] = mfma16(a3, df, acc[4 * hf + 3]);
            __builtin_amdgcn_sched_barrier(0);
        }
    }
    {
        LAS float* ob = (LAS float*)(lds + LDS_PU);
        const float* sc = p.pool_scale + l * 512 + gi * 128 + 4 * kq; f32x4 s4a[8];
#pragma unroll
        for (int nt = 0; nt < 8; ++nt) s4a[nt] = *(const f32x4*)(sc + 16 * nt);
        const int ch = lane & 15, rsub = lane >> 4; u32x4 gv[4];
#pragma unroll
        for (int it = 0; it < 4; ++it) gv[it] = __builtin_nontemporal_load((const u32x4*)(Z + (size_t)(t0 + 16 * wid + 4 * it + rsub) * INC + 512 + gi * 128 + 8 * ch));
        asm volatile("" : "+v"(s4a[0]), "+v"(s4a[1]), "+v"(s4a[2]), "+v"(s4a[3]), "+v"(s4a[4]), "+v"(s4a[5]), "+v"(s4a[6]), "+v"(s4a[7]));
        asm volatile("" : "+v"(gv[0]), "+v"(gv[1]), "+v"(gv[2]), "+v"(gv[3]));
#pragma unroll
        for (int nt = 0; nt < 8; ++nt) *(LAS f32x4*)(ob + (16 * wid + qi) * 132 + 16 * nt + 4 * kq) = acc[nt] * s4a[nt];
#pragma unroll
        for (int it = 0; it < 4; ++it) { const int row = 16 * wid + 4 * it + rsub;
            const f32x4 a0 = *(const LAS f32x4*)(ob + row * 132 + 8 * ch), a1 = *(const LAS f32x4*)(ob + row * 132 + 8 * ch + 4);
            u32x4 o; o[0] = pk2(silu(bflo(gv[it][0])) * a0[0], silu(bfhi(gv[it][0])) * a0[1]); o[1] = pk2(silu(bflo(gv[it][1])) * a0[2], silu(bfhi(gv[it][1])) * a0[3]);
            o[2] = pk2(silu(bflo(gv[it][2])) * a1[0], silu(bfhi(gv[it][2])) * a1[1]); o[3] = pk2(silu(bflo(gv[it][3])) * a1[2], silu(bfhi(gv[it][3])) * a1[3]);
            *(u32x4*)(Y + (size_t)(t0 + row) * LDY + gi * 128 + 8 * ch) = o; }
    }
    __syncthreads();
}

DI void sample_attn_item(const Params& p, int l, int b, int h, LAS unsigned char* lds) {
    const int tid = opaque_tid(), wid = __builtin_amdgcn_readfirstlane(tid >> 6), lane = tid & 63;
    const float* zs = (const float*)(p.ws + W_ZS) + (size_t)b * INC; float* ys = (float*)(p.ws + W_YS) + (size_t)b * MIXW;
    LAS float* qv = (LAS float*)lds;
    LAS float* knew = qv + 512;
    LAS float* vnew = knew + 384;
    LAS float* sc = vnew + 384;
    LAS float* st = sc + 1024;
    LAS float* red = st + 16;
    if (wid < 7) {
        float v0, v1; const int d0 = lane, d1 = lane + 64;
        if (wid < 3) { const float* s = zs + 1024 + (wid * 3 + 0) * 512 + h * 128; v0 = s[d0]; v1 = s[d1]; }
        else if (wid == 3) { const float* s = zs + 6144 + h * 128; v0 = s[d0]; v1 = s[d1]; }
        else { const float* s = zs + 1024 + ((wid - 4) * 3 + 1) * 512 + h * 128; v0 = s[d0]; v1 = s[d1]; }
        const float ss = wave_sum(v0 * v0 + v1 * v1); const float rs = rsqrtf(ss * (1.f / 128.f) + EPS);
        if (wid < 3) { const float* g = p.dil_q_norm + (l * 3 + wid) * 128; qv[wid * 128 + d0] = v0 * rs * g[d0] * ATTN_SCALE; qv[wid * 128 + d1] = v1 * rs * g[d1] * ATTN_SCALE; }
        else if (wid == 3) { const float* g = p.mem_q_norm + l * 128; qv[384 + d0] = v0 * rs * g[d0] * ATTN_SCALE; qv[384 + d1] = v1 * rs * g[d1] * ATTN_SCALE; }
        else { const int g3 = wid - 4; const float* g = p.dil_k_norm + (l * 3 + g3) * 128; const float k0 = v0 * rs * g[d0], k1 = v1 * rs * g[d1];
            const float* vs = zs + 1024 + (g3 * 3 + 2) * 512 + h * 128; const float w0 = vs[d0], w1 = vs[d1];
            knew[g3 * 128 + d0] = k0; knew[g3 * 128 + d1] = k1; vnew[g3 * 128 + d0] = w0; vnew[g3 * 128 + d1] = w1;
            const int W = 128 << (2 * g3); float* co = p.out + (g3 == 0 ? O_C128S : g3 == 1 ? O_C512S : O_C2048S) + ((size_t)(l * 8 + b) * W + (W - 1)) * 1024 + h * 128;
            co[d0] = k0; co[d1] = k1; co[512 + d0] = w0; co[512 + d1] = w1; }
    }
    __syncthreads();
    {   const int sub = lane & 15;
        for (int c7 = 0; c7 < 3; ++c7) {
            f32x4 k0[7], k1[7];
#pragma unroll
            for (int u = 0; u < 7; ++u) { const int idx = (c7 * 7 + u) * 32 + wid * 4 + (lane >> 4);
                int g, j; if (idx < 396) { g = idx / 132; j = idx % 132; } else { g = 3; j = idx - 396; }
                const bool ok = (g < 3) ? (j < 129) : (j < 256);
                const bool fromc = ok && !(g < 3 && j == 0);
                const int W = 128 << (2 * (g < 3 ? g : 0)), dil = W >> 7; const float* cb = g == 0 ? p.c128 : g == 1 ? p.c512 : g == 2 ? p.c2048 : p.cmem;
                const size_t rowi = !fromc ? 0 : (g < 3 ? (size_t)(l * 8 + b) * W + (W - dil * j) : (size_t)(l * 8 + b) * 256 + j);
                const float* kp = (fromc ? cb : p.cmem) + rowi * 1024 + h * 128;
                k0[u] = *(const f32x4*)(kp + sub * 8); k1[u] = *(const f32x4*)(kp + sub * 8 + 4); }
#pragma unroll
            for (int u = 0; u < 7; ++u) { const int idx = (c7 * 7 + u) * 32 + wid * 4 + (lane >> 4);
                int g, j; if (idx < 396) { g = idx / 132; j = idx % 132; } else { g = 3; j = idx - 396; }
                if (g < 3 && j == 0) { k0[u] = *(const LAS f32x4*)(knew + g * 128 + sub * 8); k1[u] = *(const LAS f32x4*)(knew + g * 128 + sub * 8 + 4); } }
#pragma unroll
            for (int u = 0; u < 7; ++u) { const int idx = (c7 * 7 + u) * 32 + wid * 4 + (lane >> 4);
                int g, j; if (idx < 396) { g = idx / 132; j = idx % 132; } else { g = 3; j = idx - 396; }
                const bool ok = (g < 3) ? (j < 129) : (j < 256);
                const f32x4 q0 = *(const LAS f32x4*)(qv + g * 128 + sub * 8), q1 = *(const LAS f32x4*)(qv + g * 128 + sub * 8 + 4);
                float dot = q0[0] * k0[u][0] + q0[1] * k0[u][1] + q0[2] * k0[u][2] + q0[3] * k0[u][3] + q1[0] * k1[u][0] + q1[1] * k1[u][1] + q1[2] * k1[u][2] + q1[3] * k1[u][3];
                dot = row16_sum(dot);
                if (ok && sub == 0) sc[g * 256 + j] = dot; }
        }
    }
    __syncthreads();
    if (wid < 4) { const int n = wid < 3 ? 129 : 256; float m = -INFINITY;
        for (int j = lane; j < n; j += 64) m = fmaxf(m, sc[wid * 256 + j]);
        m = wave_max(m); float sum = 0.f;
        for (int j = lane; j < n; j += 64) { const float e = __expf(sc[wid * 256 + j] - m); sc[wid * 256 + j] = e; sum += e; }
        sum = wave_sum(sum);
        if (lane == 0) { st[wid * 2] = m + __logf(sum); st[wid * 2 + 1] = 1.f / sum; } }
    __syncthreads();
    {   const int d4 = (tid & 31) * 4, part = tid >> 5;
        f32x4 vv[43];
#pragma unroll
        for (int g = 0; g < 3; ++g) { const int W = 128 << (2 * g), dil = W >> 7; const float* cb = g == 0 ? p.c128 : g == 1 ? p.c512 : p.c2048;
#pragma unroll
            for (int u = 0; u < 9; ++u) { const int j = part + 16 * u; const int jc = (j >= 1 && j < 129) ? j : 1;
                vv[g * 9 + u] = *(const f32x4*)(cb + ((size_t)(l * 8 + b) * W + (W - dil * jc)) * 1024 + 512 + h * 128 + d4); } }
#pragma unroll
        for (int g = 0; g < 3; ++g)
#pragma unroll
            for (int u = 0; u < 9; ++u) { const int j = part + 16 * u;
                if (j == 0) vv[g * 9 + u] = *(const LAS f32x4*)(vnew + g * 128 + d4);
                else if (j >= 129) vv[g * 9 + u] = (f32x4){0.f, 0.f, 0.f, 0.f}; }
#pragma unroll
        for (int u = 0; u < 16; ++u) { const int j = part + 16 * u; vv[27 + u] = *(const f32x4*)(p.cmem + ((size_t)(l * 8 + b) * 256 + j) * 1024 + 512 + h * 128 + d4); }
#pragma unroll
        for (int g = 0; g < 3; ++g) { f32x4 accv = (f32x4){0.f, 0.f, 0.f, 0.f};
#pragma unroll
            for (int u = 0; u < 9; ++u) { const int j = part + 16 * u; if (j < 129) accv += vv[g * 9 + u] * sc[g * 256 + j]; }
            *(LAS f32x4*)(red + (part * 4 + g) * 128 + d4) = accv; }
        {   f32x4 accv = (f32x4){0.f, 0.f, 0.f, 0.f};
#pragma unroll
            for (int u = 0; u < 16; ++u) accv += vv[27 + u] * sc[768 + part + 16 * u];
            *(LAS f32x4*)(red + (part * 4 + 3) * 128 + d4) = accv; }
    }
    __syncthreads();
    {   const int g = tid >> 7, d = tid & 127; float o = 0.f;
#pragma unroll
        for (int part = 0; part < 16; ++part) o += red[(part * 4 + g) * 128 + d];
        o *= st[g * 2 + 1];
        qv[g * 128 + d] = o;
    }
    __syncthreads();
    if (tid < 128) { const int d = tid; const float l0 = st[0], l1 = st[2], l2 = st[4]; const float mm = fmaxf(l0, fmaxf(l1, l2));
        const float e0 = __expf(l0 - mm), e1 = __expf(l1 - mm), e2 = __expf(l2 - mm); const float is = 1.f / (e0 + e1 + e2);
        const float yd = (e0 * qv[d] + e1 * qv[128 + d] + e2 * qv[256 + d]) * is;
        ys[512 + h * 128 + d] = silu(zs[5632 + h * 128 + d]) * yd;
        ys[1024 + h * 128 + d] = silu(zs[6656 + h * 128 + d]) * qv[384 + d]; }
    __syncthreads();
}
DI void sample_pool_item(const Params& p, int l, int b, int gi, LAS unsigned char* lds) {
    const int tid = opaque_tid();
    const float* zs = (const float*)(p.ws + W_ZS) + (size_t)b * INC; float* ys = (float*)(p.ws + W_YS) + (size_t)b * MIXW;
    LAS float* dv = (LAS float*)lds; LAS float* red = dv + 128;
    const float* stp = p.state_pool + ((size_t)(l * 8 + b) * 15) * 512 + gi * 128;
    float* spo = p.out + O_SPS + ((size_t)(l * 8 + b) * 15) * 512 + gi * 128;
    const int w = 2 << gi;
    float pscale = 0.f, pgate = 0.f;
    if (tid < 128) { pscale = p.pool_scale[l * 512 + gi * 128 + tid]; pgate = zs[512 + gi * 128 + tid]; }
    if (tid < 128) { const int c = tid; const float un = zs[gi * 128 + c]; float sv[15];
#pragma unroll
        for (int i = 0; i < 15; ++i) sv[i] = stp[i * 512 + c];
        float s = un;
#pragma unroll
        for (int i = 1; i < 16; ++i) if (i < w) s += sv[15 - i];
        dv[c] = s / (float)w - un;
#pragma unroll
        for (int i = 0; i < 14; ++i) spo[i * 512 + c] = sv[i + 1];
        spo[14 * 512 + c] = un; }
    __syncthreads();
    {   const int d = tid & 127, part = tid >> 7; const float* wp = p.pool_w + ((size_t)l * 4 + gi) * 16384 + d; float s = 0.f; float wv[32];
#pragma unroll
        for (int c = 0; c < 32; ++c) wv[c] = wp[(part * 32 + c) * 128];
#pragma unroll
        for (int c = 0; c < 32; ++c) s += dv[part * 32 + c] * wv[c];
        red[part * 128 + d] = s; }
    __syncthreads();
    if (tid < 128) { const int d = tid; const float o = (red[d] + red[128 + d] + red[256 + d] + red[384 + d]) * pscale;
        ys[gi * 128 + d] = silu(pgate) * o; }
    __syncthreads();
}

template <int K, int LD, int NB>
DI f32x4 gemv16(const LAS unsigned char* xs  , const bf16_t* Wt  , int lane, int ks0, int nks) {
    const int n = lane & 15, kq = lane >> 4;
    const bf16_t* wp = Wt + (size_t)n * LD + kq * 8; const LAS unsigned char* ap = xs + (n & 7) * (2 * K + 16) + kq * 16;
    f32x4 acc = (f32x4){0.f, 0.f, 0.f, 0.f};
    for (int ks = ks0; ks < ks0 + nks; ks += NB) {
        bf16x8 bfr[NB];
#pragma unroll
        for (int u = 0; u < NB; ++u) bfr[u] = __builtin_nontemporal_load((const bf16x8*)(wp + (ks + u) * 32));
#pragma unroll
        for (int u = 0; u < NB; ++u) { const bf16x8 afr = *(const LAS bf16x8*)(ap + (ks + u) * 64); acc = mfma16(afr, bfr[u], acc); }
    }
    return acc;
}

DI void phase_inproj(const Params& p, int l, LAS unsigned char* lds) {
    const int tid = opaque_tid(), wid = __builtin_amdgcn_readfirstlane(tid >> 6), lane = tid & 63, bid = blockIdx.x, G = gridDim.x;
    const bf16_t* WTl = (const bf16_t*)(p.ws + W_WT) + (size_t)l * 8192 * LDA;
    {   pg8::Gemm g; g.A = (const bf16_t*)(p.ws + W_AALL); g.Bt = WTl; g.K = 2048; g.ld = LDA;
        SchedIn S; S.G = G; S.c = bid;
        LAS float* rtab = (LAS float*)(lds + 131072);
        {   const float* ssq = (const float*)(p.ws + W_SSQ); const float* rmem = (const float*)(p.ws + W_RMEM);
            for (int i = 0; i < 4; ++i) { pg8::Unit u;
                if (S.next(i, u) && tid < 256) { const int row = u.pm * 256 + tid; float r;
                    if (u.pm >= 32) r = rmem[row - 8192];
                    else { const f32x4 v0 = *(const f32x4*)(ssq + (size_t)row * 8), v1 = *(const f32x4*)(ssq + (size_t)row * 8 + 4);
                        r = rsqrtf((((v0[0] + v0[1]) + (v0[2] + v0[3])) + ((v1[0] + v1[1]) + (v1[2] + v1[3]))) * (1.f / 2048.f) + EPS); }
                    rtab[i * 256 + tid] = r; } }
            __syncthreads(); }
        EpiIn E; E.z = (bf16_t*)(p.ws + W_Z); E.zmem = (bf16_t*)(p.ws + W_ZMEM); E.rtab = rtab;
        pg8::gemm_phase<EpiIn, SchedIn, GEMM_ALIGN, GEMM_SP2>(lds, g, S, E);
    }
    const int nfull = 904 - 3 * G;
    if (bid >= nfull || G != 256) {
        const int nb = (G != 256) ? G : (G - nfull), b0 = (G != 256) ? bid : (bid - nfull);
        const float* xs = (l == 0) ? p.x_sample : p.out + O_YS;
        LAS float* rs = (LAS float*)(lds + 8 * (2 * 2048 + 16));
        {   const int row = wid; float ss = 0.f; f32x4 xv[8];
#pragma unroll
            for (int it = 0; it < 8; ++it) xv[it] = *(const f32x4*)(xs + row * DM + it * 256 + lane * 4);
#pragma unroll
            for (int it = 0; it < 8; ++it) { const f32x4 v = xv[it]; ss += v[0] * v[0] + v[1] * v[1] + v[2] * v[2] + v[3] * v[3];
                u32x2 o; o[0] = pk2(v[0], v[1]); o[1] = pk2(v[2], v[3]); *(LAS u32x2*)(lds + row * (2 * 2048 + 16) + (it * 256 + lane * 4) * 2) = o; }
            ss = wave_sum(ss); if (lane == 0) rs[row] = rsqrtf(ss * (1.f / 2048.f) + EPS); }
        __syncthreads();
        float* zs = (float*)(p.ws + W_ZS);
        LAS f32x4* red = (LAS f32x4*)(lds + 33024);
        for (int t0 = b0; t0 < 448; t0 += nb * 4) {
            const int task = t0 + nb * (wid >> 1), kh = wid & 1;
            f32x4 acc = (f32x4){0.f, 0.f, 0.f, 0.f};
            if (task < 448) acc = gemv16<2048, LDA, 16>(lds, WTl + (size_t)task * 16 * LDA, lane, 32 * kh, 32);
            red[wid * 64 + lane] = acc;
            __syncthreads();
            if (kh == 0 && task < 448) { acc += red[(wid + 1) * 64 + lane];
                const int n = lane & 15, kq = lane >> 4;
                if (kq < 2) {
#pragma unroll
                    for (int j = 0; j < 4; ++j) { const int row = 4 * kq + j; zs[(size_t)row * INC + task * 16 + n] = acc[j] * rs[row]; } } }
            __syncthreads();
        }
        cache_copy_layer(p, l, b0, nb, 0, NCOPY_TAIL);
        __syncthreads();
        if (l + 1 < DEPTH) { transpose_layer(p, l + 1, 0, NTR_TAIL, b0 * 8 + wid, nb * 8, lds, wid, lane, true); __syncthreads(); }
    }
}

DI void phase_mix(const Params& p, int l, LAS unsigned char* lds) {
    const int bid = blockIdx.x, G = gridDim.x;
    const bf16_t* Z = (const bf16_t*)(p.ws + W_Z); const bf16_t* ZMEM = (const bf16_t*)(p.ws + W_ZMEM);
    for (int item = bid + 64; item < 1344; item += G) {
        if (item < 1088) {
            AttnItem a;
            if (item < 832) {
                const int e = item - 64, g = e >> 8, rem = e & 255, h = rem & 3, b = (rem >> 2) & 1, rem3 = rem >> 3;
                const int dil = 1 << (2 * g), nbq = 32 >> (2 * g), W = 128 * dil, r = rem3 / nbq, j = rem3 % nbq;
                const int qcol = 1024 + (g * 3) * 512 + h * 128;
                a.qb = Z + ((size_t)b * SEQ + (size_t)128 * j * dil + r) * INC + qcol; a.qstep = (long)dil * INC;
                a.kb = Z + ((long)b * SEQ + (long)128 * (j - 1) * dil + r) * INC + qcol + 512; a.kstep = (long)dil * INC;
                a.qgain = p.dil_q_norm + (l * 3 + g) * 128; a.kgain = p.dil_k_norm + (l * 3 + g) * 128;
                a.kzero = (j == 0); a.band = 1;
                a.cache = (j == nbq - 1) ? p.out + (g == 0 ? O_C128P : g == 1 ? O_C512P : O_C2048P) + ((size_t)(l * 2 + b) * W + r) * 1024 + h * 128 : nullptr;
                a.cstep = (long)dil * 1024; a.cache_lo = 128;
                const size_t tok0 = (size_t)b * SEQ + (size_t)128 * j * dil + r;
                a.og = (bf16_t*)(p.ws + W_OG) + ((size_t)g * NTOK + tok0) * 512 + h * 128; a.ogstep = (long)dil * 512;
                a.lse = (float*)(p.ws + W_LSE) + ((size_t)g * NTOK + tok0) * 4 + h; a.lsestep = (long)dil * 4;
                a.y = nullptr; a.gate = nullptr;
            } else {
                const int e = item - 832, h = e & 3, qb = e >> 2, b = qb >> 5;
                a.qb = Z + (size_t)qb * 128 * INC + 6144 + h * 128; a.qstep = INC;
                a.kb = ZMEM + (size_t)b * 256 * 1024 + h * 128; a.kstep = 1024;
                a.qgain = p.mem_q_norm + l * 128; a.kgain = p.mem_k_norm + l * 128;
                a.kzero = 0; a.band = 0;
                a.cache = ((qb & 31) == 0) ? p.out + O_MEMP + ((size_t)(l * 2 + b) * 256) * 1024 + h * 128 : nullptr;
                a.cstep = 1024; a.cache_lo = 0;
                a.og = nullptr; a.ogstep = 0; a.lse = nullptr; a.lsestep = 0;
                a.y = (bf16_t*)(p.ws + W_Y) + (size_t)qb * 128 * LDY + 1024 + h * 128; a.gate = Z + (size_t)qb * 128 * INC + 6656 + h * 128;
            }
#ifndef NO_ATTN
            attn_item(a, lds);
#endif
        } else { const int e = item - 1088;
#ifndef NO_POOL
            pool_item(p, l, e >> 2, e & 3, lds);
#endif
        }
    }
}

DI void phase_combine(const Params& p, int l, LAS unsigned char* lds) {
    const bf16_t* Z = (const bf16_t*)(p.ws + W_Z); const bf16_t* OG = (const bf16_t*)(p.ws + W_OG); const float* LSE = (const float*)(p.ws + W_LSE); bf16_t* Y = (bf16_t*)(p.ws + W_Y);
    const int bid = blockIdx.x, G = gridDim.x;
    if (bid < 64) {
        if (bid < 32) sample_attn_item(p, l, bid >> 2, bid & 3, lds); else sample_pool_item(p, l, (bid - 32) >> 2, bid & 3, lds);
        return;
    }
    for (int idx = (bid - 64) * 512 + opaque_tid(); idx < NTOK * 64; idx += (G - 64) * 512) {
        const int token = idx >> 6, c8 = idx & 63, h = c8 >> 4;
        const float l0 = LSE[(size_t)token * 4 + h], l1 = LSE[((size_t)NTOK + token) * 4 + h], l2 = LSE[((size_t)2 * NTOK + token) * 4 + h];
        const float mm = fmaxf(l0, fmaxf(l1, l2)); float e0 = __expf(l0 - mm), e1 = __expf(l1 - mm), e2 = __expf(l2 - mm); const float is = 1.f / (e0 + e1 + e2); e0 *= is; e1 *= is; e2 *= is;
        const u32x4 a0 = __builtin_nontemporal_load((const u32x4*)(OG + (size_t)token * 512 + c8 * 8)), a1 = __builtin_nontemporal_load((const u32x4*)(OG + ((size_t)NTOK + token) * 512 + c8 * 8)), a2 = __builtin_nontemporal_load((const u32x4*)(OG + ((size_t)2 * NTOK + token) * 512 + c8 * 8));
        const u32x4 gv = __builtin_nontemporal_load((const u32x4*)(Z + (size_t)token * INC + 5632 + c8 * 8));
        u32x4 o;
#pragma unroll
        for (int e = 0; e < 4; ++e) { const float lo = e0 * bflo(a0[e]) + e1 * bflo(a1[e]) + e2 * bflo(a2[e]), hi = e0 * bfhi(a0[e]) + e1 * bfhi(a1[e]) + e2 * bfhi(a2[e]);
            o[e] = pk2(silu(bflo(gv[e])) * lo, silu(bfhi(gv[e])) * hi); }
        *(u32x4*)(Y + (size_t)token * LDY + 512 + c8 * 8) = o;
    }
}

DI void phase_outproj(const Params& p, int l, LAS unsigned char* lds) {
    const int tid = opaque_tid(), wid = __builtin_amdgcn_readfirstlane(tid >> 6), lane = tid & 63, bid = blockIdx.x, G = gridDim.x;
    const bf16_t* WOTl = (const bf16_t*)(p.ws + W_WOT) + (size_t)l * 2048 * LDY;
    {   pg8::Gemm g; g.A = (const bf16_t*)(p.ws + W_Y); g.Bt = WOTl; g.K = 1536; g.ld = LDY;
        SchedOut S; S.G = G; S.c = bid;
        LAS float* ssl = (LAS float*)(lds + 131072);
        EpiOut E; E.xin = (l == 0) ? p.x_prompt : nullptr; E.yout = (l == DEPTH - 1) ? p.out + O_YP : nullptr; E.xb = (bf16_t*)(p.ws + W_AALL); E.ssl = ssl;
        pg8::gemm_phase<EpiOut, SchedOut, false, GEMM_SP2>(lds, g, S, E);
        __syncthreads();
        pg8::Unit u;
        if (S.next(0, u) && tid < 256) { const f32x4 v = *(const LAS f32x4*)(ssl + tid * 4); ((float*)(p.ws + W_SSQ))[(size_t)(u.pm * 256 + tid) * 8 + u.pn] = (v[0] + v[1]) + (v[2] + v[3]); }
    }
    if (bid < 128) {
        const float* ysrc = (const float*)(p.ws + W_YS);
        {   const int row = wid; f32x4 yv[6];
#pragma unroll
            for (int it = 0; it < 6; ++it) yv[it] = *(const f32x4*)(ysrc + row * MIXW + it * 256 + lane * 4);
#pragma unroll
            for (int it = 0; it < 6; ++it) { const f32x4 v = yv[it];
                u32x2 o; o[0] = pk2(v[0], v[1]); o[1] = pk2(v[2], v[3]); *(LAS u32x2*)(lds + row * (2 * 1536 + 16) + (it * 256 + lane * 4) * 2) = o; } }
        __syncthreads();
        {   const int task = bid; const f32x4 part = gemv16<1536, LDY, 6>(lds, WOTl + (size_t)task * 16 * LDY, lane, 6 * wid, 6);
            LAS f32x4* red = (LAS f32x4*)(lds + 8 * (2 * 1536 + 16));
            red[wid * 64 + lane] = part;
            __syncthreads();
            if (wid == 0) { f32x4 acc = red[lane];
#pragma unroll
                for (int w = 1; w < 8; ++w) acc += red[w * 64 + lane];
                const int n = lane & 15, kq = lane >> 4; const float* xo = (l == 0) ? p.x_sample : p.out + O_YS; float* xn = p.out + O_YS;
                if (kq < 2) {
#pragma unroll
                    for (int j = 0; j < 4; ++j) { const int row = 4 * kq + j; const size_t o = (size_t)row * DM + task * 16 + n; xn[o] = xo[o] + acc[j]; } } } }
        __syncthreads();
    }
}

#define XB_TMO      128
#define XB_XCNT(j)  (256  + 64 * (j))
#define XB_XSUB(j)  (1280 + 64 * (j))
#define XB_XGEN(j)  (2304 + 64 * (j))
#define XB_TOP      3328
#define XB_TOPGEN   3392
#define XCD_BAR_WORDS 3456
#define XB_SPIN_CAP (1u << 18)

__device__ __forceinline__ unsigned xb_ld(unsigned* p)              { return __hip_atomic_load(p, __ATOMIC_RELAXED, __HIP_MEMORY_SCOPE_AGENT); }
__device__ __forceinline__ unsigned xb_add(unsigned* p, unsigned v) { return __hip_atomic_fetch_add(p, v, __ATOMIC_RELAXED, __HIP_MEMORY_SCOPE_AGENT); }
__device__ __forceinline__ unsigned xb_xcc_id() { return (unsigned)__builtin_amdgcn_s_getreg((3 << 11) | 20) & 0xFu; }
#define XB_SPIN(cond, bar) do { unsigned _sp = 0; while (cond) { __builtin_amdgcn_s_sleep(1); \
    if ((++_sp & 255u) == 0u) { if (xb_ld(&(bar)[XB_TMO])) break; if (_sp > XB_SPIN_CAP) { atomicAdd(&(bar)[XB_TMO], 1u); break; } } } } while (0)

struct XcdBarrier {
    unsigned* bar; unsigned x;
    volatile LAS unsigned* st;
};

__device__ __forceinline__ XcdBarrier xcd_barrier_post(unsigned* bar, volatile LAS unsigned* st) {
    XcdBarrier b; b.bar = bar; b.x = xb_xcc_id(); b.st = st;
    if (threadIdx.x == 0) (void)xb_add(&bar[XB_XCNT(b.x)], 1u);
    return b;
}
__device__ __forceinline__ void xcd_barrier_complete(unsigned* bar, unsigned x, unsigned& nloc, unsigned& nx) {
    const unsigned G = gridDim.x * gridDim.y * gridDim.z;
    unsigned sum, cnt, mine, sp = 0u;
    for (;;) {
        sum = 0u; cnt = 0u; mine = 0u;
        unsigned cv[16];
        {
            const unsigned* cb = bar + XB_XCNT(0);
            asm volatile("global_load_dword %0, %16, off sc1\n\tglobal_load_dword %1, %16, off offset:256 sc1\n\tglobal_load_dword %2, %16, off offset:512 sc1\n\tglobal_load_dword %3, %16, off offset:768 sc1\n\t"
                         "global_load_dword %4, %16, off offset:1024 sc1\n\tglobal_load_dword %5, %16, off offset:1280 sc1\n\tglobal_load_dword %6, %16, off offset:1536 sc1\n\tglobal_load_dword %7, %16, off offset:1792 sc1\n\t"
                         "global_load_dword %8, %16, off offset:2048 sc1\n\tglobal_load_dword %9, %16, off offset:2304 sc1\n\tglobal_load_dword %10, %16, off offset:2560 sc1\n\tglobal_load_dword %11, %16, off offset:2816 sc1\n\t"
                         "global_load_dword %12, %16, off offset:3072 sc1\n\tglobal_load_dword %13, %16, off offset:3328 sc1\n\tglobal_load_dword %14, %16, off offset:3584 sc1\n\tglobal_load_dword %15, %16, off offset:3840 sc1\n\t"
                         "s_waitcnt vmcnt(0)"
                         : "=&v"(cv[0]), "=&v"(cv[1]), "=&v"(cv[2]), "=&v"(cv[3]), "=&v"(cv[4]), "=&v"(cv[5]), "=&v"(cv[6]), "=&v"(cv[7]),
                           "=&v"(cv[8]), "=&v"(cv[9]), "=&v"(cv[10]), "=&v"(cv[11]), "=&v"(cv[12]), "=&v"(cv[13]), "=&v"(cv[14]), "=&v"(cv[15])
                         : "v"(cb) : "memory");
        }
#pragma unroll
        for (unsigned j = 0; j < 16; ++j) { const unsigned c = cv[j]; sum += c; cnt += (c > 0u) ? 1u : 0u; mine = (j == x) ? c : mine; }
        if (sum == G) break;
        __builtin_amdgcn_s_sleep(1);
        if ((++sp & 255u) == 0u) { if (xb_ld(&bar[XB_TMO])) break; if (sp > XB_SPIN_CAP) { atomicAdd(&bar[XB_TMO], 1u); break; } }
    }
    nloc = mine > 0u ? mine : 1u; nx = cnt > 0u ? cnt : 1u;
}

__device__ __forceinline__ void xcd_barrier(const XcdBarrier& b) {
    asm volatile("s_waitcnt vmcnt(0)" ::: "memory");
    __syncthreads();
    if (threadIdx.x == 0) {
        unsigned* bar = b.bar;
        __builtin_amdgcn_s_waitcnt(0);
        unsigned nloc = b.st[0], nx = b.st[1];
        if (nloc == 0u) { xcd_barrier_complete(bar, b.x, nloc, nx); b.st[0] = nloc; b.st[1] = nx; }
        const unsigned old = xb_add(&bar[XB_XSUB(b.x)], 1u);
        const unsigned gen = old / nloc;
        if (old + 1u == (gen + 1u) * nloc) {
            __builtin_amdgcn_fence(__ATOMIC_RELEASE, "agent");
            asm volatile("s_waitcnt vmcnt(0)" ::: "memory");
            const unsigned og = xb_add(&bar[XB_TOP], 1u);
            const unsigned tg = og / nx;
            if (og + 1u == (tg + 1u) * nx) xb_add(&bar[XB_TOPGEN], 1u);
            else XB_SPIN(xb_ld(&bar[XB_TOPGEN]) == tg, bar);
            __builtin_amdgcn_fence(__ATOMIC_ACQUIRE, "agent");
            xb_add(&bar[XB_XGEN(b.x)], 1u);
            asm volatile("s_waitcnt vmcnt(0)" ::: "memory");
        } else {
            XB_SPIN(xb_ld(&bar[XB_XGEN(b.x)]) == gen, bar);
            __builtin_amdgcn_fence(__ATOMIC_ACQUIRE, "agent");
            asm volatile("s_waitcnt vmcnt(0)" ::: "memory");
        }
    }
    __syncthreads();
}

__global__ __launch_bounds__(512, 2) void mega(Params p, int ph_lo, int ph_hi, int coop) {
    extern __shared__ __attribute__((aligned(16))) unsigned char shm[];
    LAS unsigned char* lds = (LAS unsigned char*)shm;
    volatile LAS unsigned* xst = (volatile LAS unsigned*)(lds + (LDS_BYTES - 16));
    if (threadIdx.x < 2) xst[threadIdx.x] = 0u;
    __syncthreads();
    const XcdBarrier xb = xcd_barrier_post((unsigned*)(p.ws + W_BAR), xst);
    for (int ph = ph_lo; ph < ph_hi; ++ph) {
        int reps = 1;
#ifdef PROBE_PHASE
        if (ph == 0 ? (PROBE_PHASE == 0) : (((ph - 1) & 3) + 1 == PROBE_PHASE && (PROBE_PHASE != 4 || ph == 4))) reps = 2;
#endif
        for (int rep = 0; rep < reps; ++rep) {
            if (ph == 0) prep_phase(p, lds);
            else { const int l = (ph - 1) >> 2, s = (ph - 1) & 3;
                if (s == 0) phase_inproj(p, l, lds);
                else if (s == 1) phase_mix(p, l, lds);
                else if (s == 2) phase_combine(p, l, lds);
                else phase_outproj(p, l, lds); }
            if (coop && (ph + 1 < ph_hi || rep + 1 < reps)) {
                if (coop > 1) cg::this_grid().sync();
                else xcd_barrier(xb); }
        }
    }
}

extern "C" void kernel_launch(void* const* d_in, const int* in_sizes, int n_in, void* d_out, int out_size, void* d_ws, size_t ws_size, hipStream_t stream) {
    Params p{};
    p.x_prompt = (const float*)d_in[0]; p.x_sample = (const float*)d_in[1]; p.state_pool = (const float*)d_in[2]; p.c128 = (const float*)d_in[3];
    p.c512 = (const float*)d_in[4]; p.c2048 = (const float*)d_in[5]; p.cmem = (const float*)d_in[6]; p.mem_prompt = (const float*)d_in[7];
    p.norm_g = (const float*)d_in[8]; p.w_in = (const float*)d_in[9]; p.pool_w = (const float*)d_in[10]; p.pool_scale = (const float*)d_in[11];
    p.dil_q_norm = (const float*)d_in[12]; p.dil_k_norm = (const float*)d_in[13]; p.mem_norm_g = (const float*)d_in[14]; p.w_mem_kv = (const float*)d_in[15];
    p.mem_q_norm = (const float*)d_in[16]; p.mem_k_norm = (const float*)d_in[17]; p.w_out = (const float*)d_in[18];
    p.out = (float*)d_out; p.ws = (unsigned char*)d_ws;
    (void)hipFuncSetAttribute((const void*)mega, hipFuncAttributeMaxDynamicSharedMemorySize, LDS_BYTES);
    static int grid = 0;
    if (!grid) {
        int dev = 0, cus = 0, per_cu = 0;
        (void)hipGetDevice(&dev);
        (void)hipDeviceGetAttribute(&cus, hipDeviceAttributeMultiprocessorCount, dev);
        (void)hipOccupancyMaxActiveBlocksPerMultiprocessor(&per_cu, (const void*)mega, 512, LDS_BYTES);
        if (per_cu < 1) per_cu = 1;
        if (per_cu > 1) per_cu = 1;
        grid = cus * per_cu;
        if (grid > 256) grid = 256;
    }
    (void)hipMemsetAsync((unsigned char*)d_ws + W_BAR, 0, 16384, stream);
    int ph_lo = 0, ph_hi = NPHASE, coop = 1;
    void* args[] = {&p, &ph_lo, &ph_hi, &coop};
    hipError_t e = hipLaunchCooperativeKernel((const void*)mega, dim3(grid), dim3(512), args, LDS_BYTES, stream);
    if (e != hipSuccess) fprintf(stderr, "cooperative launch failed: %s (grid %d)\n", hipGetErrorString(e), grid);
}
```

```cpp
#include <hip/hip_runtime.h>
#include <hip/hip_cooperative_groups.h>
#include <cstdio>
#include <cstdint>
namespace cg = cooperative_groups;

#define LAS __attribute__((address_space(3)))
#define DI __device__ __forceinline__
typedef unsigned short bf16_t;
typedef short bf16x8 __attribute__((ext_vector_type(8)));
typedef short s16x4 __attribute__((ext_vector_type(4)));
typedef float f32x4 __attribute__((ext_vector_type(4)));
typedef unsigned u32x4 __attribute__((ext_vector_type(4)));
typedef unsigned u32x2 __attribute__((ext_vector_type(2)));

constexpr int DM = 2048, SEQ = 4096, NTOK = 8192, DEPTH = 4, SBATCH = 8, INC = 7168, MIXW = 1536;
constexpr int LDA = 2048 + 128;
constexpr int LDY = 1536 + 128;
constexpr int NMEM = 512;
constexpr float EPS = 1e-6f;
constexpr float ATTN_SCALE = 0.08838834764831845f;
constexpr int LDS_BYTES = 147456;
constexpr int NPHASE = 1 + 4 * DEPTH;

constexpr size_t O_YP = 0;
constexpr size_t O_YS = O_YP + (size_t)2 * 4096 * 2048;
constexpr size_t O_SPP = O_YS + (size_t)8 * 2048;
constexpr size_t O_C128P = O_SPP + (size_t)4 * 2 * 15 * 512;
constexpr size_t O_C512P = O_C128P + (size_t)4 * 2 * 128 * 1024;
constexpr size_t O_C2048P = O_C512P + (size_t)4 * 2 * 512 * 1024;
constexpr size_t O_MEMP = O_C2048P + (size_t)4 * 2 * 2048 * 1024;
constexpr size_t O_SPS = O_MEMP + (size_t)4 * 2 * 256 * 1024;
constexpr size_t O_C128S = O_SPS + (size_t)4 * 8 * 15 * 512;
constexpr size_t O_C512S = O_C128S + (size_t)4 * 8 * 128 * 1024;
constexpr size_t O_C2048S = O_C512S + (size_t)4 * 8 * 512 * 1024;

constexpr size_t W_WT = 0;
constexpr size_t W_WOT = W_WT + (size_t)4 * 8192 * LDA * 2;
constexpr size_t W_AALL = W_WOT + (size_t)4 * 2048 * LDY * 2;
constexpr size_t W_Z = W_AALL + (size_t)8704 * LDA * 2;
constexpr size_t W_ZMEM = W_Z + (size_t)8192 * 7168 * 2;
constexpr size_t W_Y = W_ZMEM + (size_t)512 * 1024 * 2;
constexpr size_t W_OG = W_Y + (size_t)8192 * LDY * 2;
constexpr size_t W_LSE = W_OG + (size_t)3 * 8192 * 512 * 2;
constexpr size_t W_SSQ = W_LSE + (size_t)3 * 8192 * 4 * 4;
constexpr size_t W_RMEM = W_SSQ + (size_t)8192 * 32 * 4;
constexpr size_t W_ZS = W_RMEM + 4096;
constexpr size_t W_YS = W_ZS + (size_t)8 * 7168 * 4;
constexpr size_t W_BAR = W_YS + (size_t)8 * 1536 * 4;
constexpr size_t W_END = W_BAR + 16384;

struct Params {
    const float *x_prompt, *x_sample, *state_pool, *c128, *c512, *c2048, *cmem, *mem_prompt, *norm_g, *w_in, *pool_w, *pool_scale,
        *dil_q_norm, *dil_k_norm, *mem_norm_g, *w_mem_kv, *mem_q_norm, *mem_k_norm, *w_out;
    float* out;
    unsigned char* ws;
};

DI unsigned short f2bf(float f) { unsigned u = __float_as_uint(f); u += 0x7fffu + ((u >> 16) & 1u); return (unsigned short)(u >> 16); }
typedef __bf16 hbf16x2 __attribute__((ext_vector_type(2)));
typedef float f32x2 __attribute__((ext_vector_type(2)));
DI unsigned pk2(float lo, float hi) { const f32x2 f = {lo, hi}; return __builtin_bit_cast(unsigned, __builtin_convertvector(f, hbf16x2)); }
DI float bf2f(unsigned short b) { return __uint_as_float(((unsigned)b) << 16); }
DI float bflo(unsigned u) { return __uint_as_float(u << 16); }
DI float bfhi(unsigned u) { return __uint_as_float(u & 0xffff0000u); }
DI float silu(float x) { return x / (1.f + __expf(-x)); }
DI float wave_sum(float v) {
#pragma unroll
    for (int o = 32; o >= 1; o >>= 1) v += __shfl_xor(v, o);
    return v;
}
DI float dpp_add(float v, const int ctrl_is) { return v; }
DI float row16_sum(float v) {
    v += __builtin_bit_cast(float, __builtin_amdgcn_update_dpp(0, __builtin_bit_cast(int, v), 0xB1, 0xF, 0xF, true));
    v += __builtin_bit_cast(float, __builtin_amdgcn_update_dpp(0, __builtin_bit_cast(int, v), 0x4E, 0xF, 0xF, true));
    v += __builtin_bit_cast(float, __builtin_amdgcn_update_dpp(0, __builtin_bit_cast(int, v), 0x141, 0xF, 0xF, true));
    v += __builtin_bit_cast(float, __builtin_amdgcn_update_dpp(0, __builtin_bit_cast(int, v), 0x140, 0xF, 0xF, true));
    return v;
}
DI float wave_max(float v) {
#pragma unroll
    for (int o = 32; o >= 1; o >>= 1) v = fmaxf(v, __shfl_xor(v, o));
    return v;
}
DI int opaque_tid() { int t = threadIdx.x; asm volatile("" : "+v"(t)); return t; }
DI f32x4 mfma16(bf16x8 a, bf16x8 b, f32x4 c) { return __builtin_amdgcn_mfma_f32_16x16x32_bf16(a, b, c, 0, 0, 0); }

namespace pg8 {
constexpr int BM = 256, BK = 64, HALF = 128, HTB = HALF * BK * 2, STAGE_BYTES = 8 * HTB, NXCD = 8, WGM = 8;
DI int lds_byte(int r, int c) { const int st = (r >> 4) * 2 + (c >> 5), rr = r & 15, cc = c & 31, ob = rr * 64 + cc * 2; return st * 1024 + (ob ^ (((ob >> 9) & 1) << 5)); }
DI void stage_rc(int b, int& R, int& C) { const int st = b / 1024, sb = b % 1024, swz = sb ^ (((sb >> 9) & 1) << 5); R = (st >> 1) * 16 + swz / 64; C = (st & 1) * 32 + (swz % 64) / 2; }
DI int perm32(int rho) { const int n = rho >> 4, i = rho & 15; return 8 * (i >> 2) + 4 * n + (i & 3); }
struct Unit { int pm, pn; };
struct Gemm { const bf16_t* A; const bf16_t* Bt; int K, ld; };

DI bool static_unit(int L, int nM, int nN, Unit& u) {
    const int nwg = nM * nN;
    int wgid = L; { const int q = nwg / NXCD, r = nwg % NXCD, xcd = wgid % NXCD, off = wgid / NXCD; wgid = (xcd < r ? xcd * (q + 1) : r * (q + 1) + (xcd - r) * q) + off; }
    const int nig = WGM * nN, gid = wgid / nig, fm = gid * WGM, gsz = (nM - fm) < WGM ? (nM - fm) : WGM;
    u.pm = fm + ((wgid % nig) % gsz); u.pn = (wgid % nig) / gsz; return true;
}

template <class Epi, class Sched, bool ALIGN_EPI, bool SP2>
DI void gemm_phase(LAS unsigned char* lds, const Gemm g, const Sched& S, const Epi& E) {
    const int tid = opaque_tid(), wid = __builtin_amdgcn_readfirstlane(tid >> 6), lane = tid & 63, wr = wid >> 2, wc = wid & 3, fr = lane & 15, fq = lane >> 4;
    const int K = g.K, nt = K / BK, ld = g.ld;
    unsigned voffA[2], voffB[2];
#pragma unroll
    for (int i = 0; i < 2; ++i) { int R, C; stage_rc(tid * 16 + i * 8192, R, C); const int Rb = (R & ~31) + perm32(R & 31);
        voffA[i] = (unsigned)(R * ld + C) * 2u; voffB[i] = (unsigned)(Rb * ld + C) * 2u; }
    const size_t kstep = (size_t)(BK * 2);
    const size_t hstep = (size_t)HALF * ld * 2;
    const size_t tstep = 2 * hstep;
    const unsigned ldsw = (unsigned)wid * 1024u;
    const int aoff = lds_byte(wr * 64 + fr, fq * 8), boff = lds_byte(wc * 32 + fr, fq * 8);
#define PG8_SA(b, h) (((b) * 2 + (h)) * HTB)
#define PG8_SB(b, h) ((4 + (b) * 2 + (h)) * HTB)
#define PG8_STAGE(bufoff, gbase, voff) do { _Pragma("unroll") for (int _i = 0; _i < 2; ++_i) \
        __builtin_amdgcn_global_load_lds((const unsigned*)((const char*)(gbase) + (voff)[_i]), (LAS unsigned*)(lds + (bufoff) + ldsw + _i * 8192), 16, 0, 0); } while (0)
#define PG8_LDA(dst, b, h) do { _Pragma("unroll") for (int m = 0; m < 4; ++m) _Pragma("unroll") for (int k = 0; k < 2; ++k) dst[m][k] = *(const LAS bf16x8*)(lds + PG8_SA(b, h) + aoff + m * 2048 + k * 1024); } while (0)
#define PG8_LDB(dst, b, h) do { _Pragma("unroll") for (int n = 0; n < 2; ++n) _Pragma("unroll") for (int k = 0; k < 2; ++k) dst[n][k] = *(const LAS bf16x8*)(lds + PG8_SB(b, h) + boff + n * 2048 + k * 1024); } while (0)
#define PG8_MMA(ai, bj, At, Bt) do { __builtin_amdgcn_s_setprio(1); _Pragma("unroll") for (int m = 0; m < 4; ++m) _Pragma("unroll") for (int n = 0; n < 2; ++n) _Pragma("unroll") for (int k = 0; k < 2; ++k) \
        acc[ai][bj][m][n] = __builtin_amdgcn_mfma_f32_16x16x32_bf16(Bt[n][k], At[m][k], acc[ai][bj][m][n], 0, 0, 0); __builtin_amdgcn_s_setprio(0); } while (0)
#define PG8_WAIT_V(n) asm volatile("s_waitcnt vmcnt(" #n ")" ::: "memory")
#define PG8_WAIT_L(n) asm volatile("s_waitcnt lgkmcnt(" #n ")" ::: "memory")
#define PG8_BAR __builtin_amdgcn_s_barrier()
#define PG8_SCHED __builtin_amdgcn_sched_barrier(0)
    Unit cur, nxt; int ui = 0;
    if (!S.next(0, cur)) return;
    f32x4 acc[2][2][4][2];
#pragma unroll
    for (int a = 0; a < 2; ++a)
#pragma unroll
        for (int b = 0; b < 2; ++b)
#pragma unroll
            for (int m = 0; m < 4; ++m)
#pragma unroll
                for (int n = 0; n < 2; ++n) acc[a][b][m][n] = (f32x4){0.f, 0.f, 0.f, 0.f};
    bf16x8 At[4][2], B0[2][2], B1[2][2];
    const char* cA = (const char*)g.A + (size_t)cur.pm * tstep; const char* cB = (const char*)g.Bt + (size_t)cur.pn * tstep;
    if constexpr (SP2) {
        PG8_STAGE(PG8_SB(0, 0), cB, voffB); PG8_STAGE(PG8_SB(0, 1), cB + hstep, voffB); PG8_STAGE(PG8_SA(0, 0), cA, voffA); PG8_STAGE(PG8_SA(0, 1), cA + hstep, voffA);
        if (wr == 1) PG8_BAR;
        PG8_WAIT_V(2); PG8_BAR;
        PG8_STAGE(PG8_SB(1, 0), cB + kstep, voffB); PG8_STAGE(PG8_SA(1, 0), cA + kstep, voffA); PG8_STAGE(PG8_SB(1, 1), cB + hstep + kstep, voffB);
        PG8_WAIT_V(6); PG8_BAR;
    } else {
        PG8_STAGE(PG8_SB(0, 0), cB, voffB); PG8_STAGE(PG8_SA(0, 0), cA, voffA); PG8_STAGE(PG8_SB(0, 1), cB + hstep, voffB); PG8_STAGE(PG8_SA(0, 1), cA + hstep, voffA);
        if (wr == 1) PG8_BAR;
        PG8_WAIT_V(4); PG8_BAR;
        PG8_STAGE(PG8_SB(1, 0), cB + kstep, voffB); PG8_STAGE(PG8_SA(1, 0), cA + kstep, voffA); PG8_STAGE(PG8_SB(1, 1), cB + hstep + kstep, voffB);
        PG8_WAIT_V(6); PG8_BAR;
    }
    for (;;) {
        const bool has_next = S.next(ui + 1, nxt);
        const char* nA = has_next ? (const char*)g.A + (size_t)nxt.pm * tstep : cA; const char* nB = has_next ? (const char*)g.Bt + (size_t)nxt.pn * tstep : cB;
        for (int t = 0; t < nt; t += 2) {
            const bool last = (t == nt - 2);
            const char* a1 = cA + (size_t)(t + 1) * kstep;
            const char* a2 = last ? nA : cA + (size_t)(t + 2) * kstep; const char* b2 = last ? nB : cB + (size_t)(t + 2) * kstep;
            const char* a3 = a2 + kstep; const char* b3 = b2 + kstep;
            if constexpr (SP2) {
            PG8_LDB(B0, 0, 0); PG8_LDB(B1, 0, 1); PG8_SCHED; PG8_LDA(At, 0, 0); PG8_STAGE(PG8_SA(1, 1), a1 + hstep, voffA);
            PG8_WAIT_V(8); PG8_WAIT_L(0); PG8_BAR; PG8_MMA(0, 0, At, B0); PG8_MMA(0, 1, At, B1); PG8_BAR; PG8_SCHED;
            PG8_LDA(At, 0, 1); PG8_STAGE(PG8_SB(0, 0), b2, voffB); PG8_STAGE(PG8_SB(0, 1), b2 + hstep, voffB); PG8_STAGE(PG8_SA(0, 0), a2, voffA);
            PG8_WAIT_V(8); PG8_WAIT_L(0); PG8_BAR; PG8_MMA(1, 0, At, B0); PG8_MMA(1, 1, At, B1); PG8_BAR; PG8_SCHED;
            PG8_LDB(B0, 1, 0); PG8_LDB(B1, 1, 1); PG8_SCHED; PG8_LDA(At, 1, 0); PG8_STAGE(PG8_SA(0, 1), a2 + hstep, voffA);
            PG8_WAIT_V(8); PG8_WAIT_L(0); PG8_BAR; PG8_MMA(0, 0, At, B0); PG8_MMA(0, 1, At, B1); PG8_BAR; PG8_SCHED;
            PG8_LDA(At, 1, 1); PG8_STAGE(PG8_SB(1, 0), b3, voffB); PG8_STAGE(PG8_SB(1, 1), b3 + hstep, voffB); PG8_STAGE(PG8_SA(1, 0), a3, voffA);
            PG8_WAIT_V(8); PG8_WAIT_L(0); PG8_BAR; PG8_MMA(1, 0, At, B0); PG8_MMA(1, 1, At, B1); PG8_BAR; PG8_SCHED;
            } else {
            PG8_LDB(B0, 0, 0); PG8_SCHED; PG8_LDA(At, 0, 0); PG8_STAGE(PG8_SA(1, 1), a1 + hstep, voffA);
            PG8_WAIT_L(8); PG8_BAR; PG8_WAIT_L(0); PG8_MMA(0, 0, At, B0); PG8_BAR; PG8_SCHED;
            PG8_LDB(B1, 0, 1); PG8_STAGE(PG8_SB(0, 0), b2, voffB);
            PG8_BAR; PG8_WAIT_L(0); PG8_MMA(0, 1, At, B1); PG8_BAR;
            PG8_LDA(At, 0, 1); PG8_STAGE(PG8_SA(0, 0), a2, voffA);
            PG8_BAR; PG8_WAIT_L(0); PG8_MMA(1, 0, At, B0); PG8_BAR; PG8_SCHED;
            PG8_STAGE(PG8_SB(0, 1), b2 + hstep, voffB);
            PG8_WAIT_V(6); PG8_BAR; PG8_MMA(1, 1, At, B1); PG8_BAR;
            PG8_LDB(B0, 1, 0); PG8_SCHED; PG8_LDA(At, 1, 0); PG8_STAGE(PG8_SA(0, 1), a2 + hstep, voffA);
            PG8_WAIT_L(8); PG8_BAR; PG8_WAIT_L(0); PG8_MMA(0, 0, At, B0); PG8_BAR; PG8_SCHED;
            PG8_LDB(B1, 1, 1); PG8_STAGE(PG8_SB(1, 0), b3, voffB);
            PG8_BAR; PG8_WAIT_L(0); PG8_MMA(0, 1, At, B1); PG8_BAR;
            PG8_LDA(At, 1, 1); PG8_STAGE(PG8_SA(1, 0), a3, voffA);
            PG8_BAR; PG8_WAIT_L(0); PG8_MMA(1, 0, At, B0); PG8_BAR; PG8_SCHED;
            PG8_STAGE(PG8_SB(1, 1), b3 + hstep, voffB);
            PG8_WAIT_V(6); PG8_BAR; PG8_MMA(1, 1, At, B1); PG8_BAR;
            }
        }
        if constexpr (ALIGN_EPI) { if (wr == 0) PG8_BAR; }
        E(acc, cur, ui, wr, wc, fr, fq);
        if (!has_next) break;
#pragma unroll
        for (int a = 0; a < 2; ++a)
#pragma unroll
            for (int b = 0; b < 2; ++b)
#pragma unroll
                for (int m = 0; m < 4; ++m)
#pragma unroll
                    for (int n = 0; n < 2; ++n) acc[a][b][m][n] = (f32x4){0.f, 0.f, 0.f, 0.f};
        cur = nxt; cA = nA; cB = nB; ++ui;
        if constexpr (ALIGN_EPI) { if (wr == 1) PG8_BAR; }
    }
    PG8_WAIT_V(0);
    if constexpr (!ALIGN_EPI) { if (wr == 0) PG8_BAR; }
    PG8_BAR;
#undef PG8_SA
#undef PG8_SB
#undef PG8_STAGE
#undef PG8_LDA
#undef PG8_LDB
#undef PG8_MMA
#undef PG8_WAIT_V
#undef PG8_WAIT_L
#undef PG8_BAR
#undef PG8_SCHED
}
}

constexpr bool GEMM_SP2 = true, GEMM_ALIGN = true;
struct SchedIn {
    int G, c;
    DI bool next(int i, pg8::Unit& u) const {
        const int L = i * G + c;
        if (L >= 904) return false;
        if (L >= 896) { const int e = L - 896; u.pm = 32 + (e >> 2); u.pn = 28 + (e & 3); return true; }
        return pg8::static_unit(L, 32, 28, u);
    }
};
struct SchedOut {
    int G, c;
    DI bool next(int i, pg8::Unit& u) const {
        const int L = i * G + c;
        if (L >= 256) return false;
        return pg8::static_unit(L, 32, 8, u);
    }
};
struct EpiIn {
    bf16_t* z; bf16_t* zmem; const LAS float* rtab;
    DI void operator()(const f32x4 (&acc)[2][2][4][2], const pg8::Unit& u, int ui, int wr, int wc, int fr, int fq) const {
        const bool ismem = u.pm >= 32;
        const int row0 = u.pm * 256 + wr * 64 + fr;
        const int colt = (ismem ? (u.pn - 28) : u.pn) * 256 + wc * 32 + 8 * fq;
        const int ldc = ismem ? 1024 : INC;
        bf16_t* base = ismem ? zmem - (size_t)8192 * 1024 : z;
#pragma unroll
        for (int ai = 0; ai < 2; ++ai)
#pragma unroll
            for (int m = 0; m < 4; ++m) {
                const int row = row0 + ai * 128 + m * 16;
                const float r = rtab[ui * 256 + wr * 64 + fr + ai * 128 + m * 16];
                bf16_t* rowp = base + (size_t)row * ldc + colt;
#pragma unroll
                for (int bj = 0; bj < 2; ++bj) { const f32x4 v0 = acc[ai][bj][m][0] * r, v1 = acc[ai][bj][m][1] * r;
                    u32x4 o; o[0] = pk2(v0[0], v0[1]); o[1] = pk2(v0[2], v0[3]); o[2] = pk2(v1[0], v1[1]); o[3] = pk2(v1[2], v1[3]);
                    *(u32x4*)(rowp + bj * 128) = o; }
            }
    }
};
struct EpiOut {
    const float* xin;
    float* yout;
    bf16_t* xb; LAS float* ssl;
    DI void operator()(const f32x4 (&acc)[2][2][4][2], const pg8::Unit& u, int ui, int wr, int wc, int fr, int fq) const {
        const int row0 = u.pm * 256 + wr * 64 + fr, col0 = u.pn * 256 + wc * 32 + 8 * fq;
#pragma unroll
        for (int ah = 0; ah < 4; ++ah) {
            const int ai = ah >> 1, mh = ah & 1;
            f32x4 xo[8];
            if (xin) {
#pragma unroll
                for (int mm = 0; mm < 2; ++mm)
#pragma unroll
                    for (int bj = 0; bj < 2; ++bj) { const size_t o = (size_t)(row0 + ai * 128 + (2 * mh + mm) * 16) * DM + col0 + bj * 128;
                        xo[(mm * 2 + bj) * 2] = __builtin_nontemporal_load((const f32x4*)(xin + o)); xo[(mm * 2 + bj) * 2 + 1] = __builtin_nontemporal_load((const f32x4*)(xin + o + 4)); }
                asm volatile("" : "+v"(xo[0]), "+v"(xo[1]), "+v"(xo[2]), "+v"(xo[3]), "+v"(xo[4]), "+v"(xo[5]), "+v"(xo[6]), "+v"(xo[7]));
            } else {
                u32x4 xq[4];
#pragma unroll
                for (int mm = 0; mm < 2; ++mm)
#pragma unroll
                    for (int bj = 0; bj < 2; ++bj) xq[mm * 2 + bj] = *(const u32x4*)(xb + (size_t)(row0 + ai * 128 + (2 * mh + mm) * 16) * LDA + col0 + bj * 128);
                asm volatile("" : "+v"(xq[0]), "+v"(xq[1]), "+v"(xq[2]), "+v"(xq[3]));
#pragma unroll
                for (int q = 0; q < 4; ++q) { xo[2 * q] = (f32x4){bflo(xq[q][0]), bfhi(xq[q][0]), bflo(xq[q][1]), bfhi(xq[q][1])}; xo[2 * q + 1] = (f32x4){bflo(xq[q][2]), bfhi(xq[q][2]), bflo(xq[q][3]), bfhi(xq[q][3])}; }
            }
#pragma unroll
            for (int mm = 0; mm < 2; ++mm) {
                const int m = 2 * mh + mm, row = row0 + ai * 128 + m * 16; float ss = 0.f;
#pragma unroll
                for (int bj = 0; bj < 2; ++bj) {
                    const f32x4 v0 = acc[ai][bj][m][0] + xo[(mm * 2 + bj) * 2], v1 = acc[ai][bj][m][1] + xo[(mm * 2 + bj) * 2 + 1];
                    if (yout) { const size_t o = (size_t)row * DM + col0 + bj * 128;
                        __builtin_nontemporal_store(v0, (f32x4*)(yout + o)); __builtin_nontemporal_store(v1, (f32x4*)(yout + o + 4)); }
                    else { u32x4 pb; pb[0] = pk2(v0[0], v0[1]); pb[1] = pk2(v0[2], v0[3]); pb[2] = pk2(v1[0], v1[1]); pb[3] = pk2(v1[2], v1[3]);
                        *(u32x4*)(xb + (size_t)row * LDA + col0 + bj * 128) = pb; }
                    ss += v0[0] * v0[0] + v0[1] * v0[1] + v0[2] * v0[2] + v0[3] * v0[3] + v1[0] * v1[0] + v1[1] * v1[1] + v1[2] * v1[2] + v1[3] * v1[3]; }
                ss += __shfl_xor(ss, 16); ss += __shfl_xor(ss, 32);
                if (fq == 0) ssl[(ai * 128 + wr * 64 + m * 16 + fr) * 4 + wc] = ss;
            }
        }
    }
};

constexpr int NCOPY_TAIL = 2688;
DI void cache_copy_layer(const Params& p, int l, int first, int stride, int lo, int hi) {
    const int tid = opaque_tid();
    if (lo + first >= hi) return;
    for (int u0 = lo + first; u0 < hi; u0 += 4 * stride) {
        f32x4 v[16]; f32x4* dp[4]; int idx[4][4];
#pragma unroll
        for (int hf = 0; hf < 4; ++hf) {
            const int uu = u0 + hf * stride, u = uu < hi ? uu : u0;
            const int b = u / 336, e = u % 336; int W, c; const float* src; float* dst;
            if (e < 16) { W = 128; c = e; src = p.c128; dst = p.out + O_C128S; }
            else if (e < 80) { W = 512; c = e - 16; src = p.c512; dst = p.out + O_C512S; }
            else { W = 2048; c = e - 80; src = p.c2048; dst = p.out + O_C2048S; }
            const size_t base = (size_t)(l * 8 + b) * W * 1024 + (size_t)c * 8192;
            const int n4 = min(8192, (W - 1) * 1024 - c * 8192) >> 2;
            const f32x4* s4 = (const f32x4*)(src + base + 1024); dp[hf] = (f32x4*)(dst + base);
#pragma unroll
            for (int k = 0; k < 4; ++k) { idx[hf][k] = min(tid + k * 512, n4 - 1); v[hf * 4 + k] = __builtin_nontemporal_load(s4 + idx[hf][k]); }
        }
#pragma unroll
        for (int hf = 0; hf < 4; ++hf)
#pragma unroll
            for (int k = 0; k < 4; ++k) __builtin_nontemporal_store(v[hf * 4 + k], dp[hf] + idx[hf][k]);
    }
}

DI void transpose_tile_w(const float* src, int ldn, const float* gain, bf16_t* dst, int ldk, int k0, int n0, LAS float* tile  , int lane, bool stream) {
    f32x4 v[16]; float gg[16];
    const int c4 = (lane & 15) * 4, rr = lane >> 4;
#pragma unroll
    for (int it = 0; it < 16; ++it) v[it] = __builtin_nontemporal_load((const f32x4*)(src + (size_t)(k0 + it * 4 + rr) * ldn + n0 + c4));
#pragma unroll
    for (int it = 0; it < 16; ++it) gg[it] = 1.f;
    if (gain) {
#pragma unroll
        for (int it = 0; it < 16; ++it) gg[it] = gain[k0 + it * 4 + rr]; }
#pragma unroll
    for (int it = 0; it < 16; ++it) { const int r = it * 4 + rr;
        tile[r * 65 + c4 + 0] = v[it][0] * gg[it]; tile[r * 65 + c4 + 1] = v[it][1] * gg[it]; tile[r * 65 + c4 + 2] = v[it][2] * gg[it]; tile[r * 65 + c4 + 3] = v[it][3] * gg[it]; }
#pragma unroll
    for (int it = 0; it < 8; ++it) { const int n = it * 8 + (lane >> 3), kc = (lane & 7) * 8; float t[8];
#pragma unroll
        for (int e = 0; e < 8; ++e) t[e] = tile[(kc + e) * 65 + n];
        u32x4 o; o[0] = pk2(t[0], t[1]); o[1] = pk2(t[2], t[3]); o[2] = pk2(t[4], t[5]); o[3] = pk2(t[6], t[7]);
        u32x4* dp = (u32x4*)(dst + (size_t)(n0 + n) * ldk + k0 + kc);
        if (stream) __builtin_nontemporal_store(o, dp); else *dp = o; }
}

constexpr int NTR_TAIL = 4864;
DI void transpose_layer(const Params& p, int l, int lo, int hi, int w0, int nw, LAS unsigned char* lds, int wid, int lane, bool stream) {
    bf16_t* WT = (bf16_t*)(p.ws + W_WT); bf16_t* WOT = (bf16_t*)(p.ws + W_WOT);
    LAS float* tile = (LAS float*)lds + wid * (64 * 65);
    for (int r = lo + w0; r < hi; r += nw) {
        if (r < 3584) { const int kt = r / 112, nt = r % 112;
            transpose_tile_w(p.w_in + (size_t)l * DM * INC, INC, p.norm_g + l * DM, WT + (size_t)l * 8192 * LDA, LDA, kt * 64, nt * 64, tile, lane, stream); }
        else if (r < 4096) { const int e = r - 3584, kt = e / 16, nt = e % 16;
            transpose_tile_w(p.w_mem_kv + (size_t)l * DM * 1024, 1024, p.mem_norm_g + l * DM, WT + (size_t)l * 8192 * LDA + (size_t)7168 * LDA, LDA, kt * 64, nt * 64, tile, lane, stream); }
        else { const int e = r - 4096, kt = e / 32, nt = e % 32;
            transpose_tile_w(p.w_out + (size_t)l * MIXW * DM, DM, nullptr, WOT + (size_t)l * 2048 * LDY, LDY, kt * 64, nt * 64, tile, lane, stream); }
    }
}

DI void prep_phase(const Params& p, LAS unsigned char* lds) {
    const int tid = opaque_tid(), wid = __builtin_amdgcn_readfirstlane(tid >> 6), lane = tid & 63, bid = blockIdx.x, G = gridDim.x;
    bf16_t* WT = (bf16_t*)(p.ws + W_WT); bf16_t* WOT = (bf16_t*)(p.ws + W_WOT); bf16_t* AALL = (bf16_t*)(p.ws + W_AALL);
    float* SSQ = (float*)(p.ws + W_SSQ); float* RMEM = (float*)(p.ws + W_RMEM);
    for (int row = bid * 8 + wid; row < NTOK + NMEM; row += G * 8) {
        const float* src = row < NTOK ? p.x_prompt + (size_t)row * DM : p.mem_prompt + (size_t)(row - NTOK) * DM;
        bf16_t* dst = AALL + (size_t)row * LDA; float ss = 0.f; f32x4 xv[8];
#pragma unroll
        for (int it = 0; it < 8; ++it) xv[it] = __builtin_nontemporal_load((const f32x4*)(src + it * 256 + lane * 4));
#pragma unroll
        for (int it = 0; it < 8; ++it) { const f32x4 v = xv[it];
            ss += v[0] * v[0] + v[1] * v[1] + v[2] * v[2] + v[3] * v[3];
            u32x2 o; o[0] = pk2(v[0], v[1]); o[1] = pk2(v[2], v[3]); *(u32x2*)(dst + it * 256 + lane * 4) = o; }
        ss = wave_sum(ss);
        if (row < NTOK) { if (lane < 8) SSQ[(size_t)row * 8 + lane] = lane == 0 ? ss : 0.f; }
        else if (lane == 0) RMEM[row - NTOK] = rsqrtf(ss * (1.f / 2048.f) + EPS);
    }
    transpose_layer(p, 0, 0, 4864, bid * 8 + wid, G * 8, lds, wid, lane, false);
    for (int l = 1; l < DEPTH; ++l) transpose_layer(p, l, NTR_TAIL, 4864, bid * 8 + wid, G * 8, lds, wid, lane, true);
    __syncthreads();
    for (int l = 0; l < DEPTH; ++l) cache_copy_layer(p, l, bid, G, NCOPY_TAIL, 2688);
}

constexpr int KSTR = 272;
constexpr int LDS_K = 0, LDS_V = 256 * KSTR;

DI void tr_read8(unsigned addr, s16x4 (&lo)[4], s16x4 (&hi)[4], int) {}

struct AttnItem {
    const bf16_t* qb; long qstep;
    const bf16_t* kb; long kstep;
    const float* qgain; const float* kgain;
    int kzero;
    int band;
    float* cache; long cstep; int cache_lo;
    bf16_t* og; long ogstep;
    float* lse; long lsestep;
    bf16_t* y; const bf16_t* gate;
};

DI void attn_item(const AttnItem& a, LAS unsigned char* lds) {
    const int tid = opaque_tid(), wid = __builtin_amdgcn_readfirstlane(tid >> 6), lane = tid & 63;
    const unsigned lbase = (unsigned)(uintptr_t)lds;
    const int qi = lane & 15, kq = lane >> 4;
    u32x4 qraw[4];
    {   const bf16_t* qp = a.qb + (long)(16 * wid + qi) * a.qstep + 8 * kq;
#pragma unroll
        for (int ks = 0; ks < 4; ++ks) qraw[ks] = __builtin_nontemporal_load((const u32x4*)(qp + 32 * ks)); }
    {   const int sub = lane & 15; float kg[8];
#pragma unroll
        for (int e = 0; e < 8; ++e) kg[e] = a.kgain[sub * 8 + e];
        u32x4 kraw[8], vraw[8];
#pragma unroll
        for (int it = 0; it < 8; ++it) {
            const int kk = it * 32 + wid * 4 + (lane >> 4);
            kraw[it] = (u32x4){0u, 0u, 0u, 0u}; vraw[it] = (u32x4){0u, 0u, 0u, 0u};
            if (!(a.kzero && it < 4)) { const bf16_t* kp = a.kb + (long)kk * a.kstep + sub * 8; kraw[it] = *(const u32x4*)kp; vraw[it] = *(const u32x4*)(kp + 512); }
        }
#pragma unroll
        for (int it = 0; it < 8; ++it) {
            const int kk = it * 32 + wid * 4 + (lane >> 4);
            float kf[8]; float ss = 0.f;
#pragma unroll
            for (int e = 0; e < 4; ++e) { kf[2 * e] = bflo(kraw[it][e]); kf[2 * e + 1] = bfhi(kraw[it][e]); ss += kf[2 * e] * kf[2 * e] + kf[2 * e + 1] * kf[2 * e + 1]; }
            ss = row16_sum(ss);
            const float rs = rsqrtf(ss * (1.f / 128.f) + EPS);
#pragma unroll
            for (int e = 0; e < 8; ++e) kf[e] *= rs * kg[e];
            u32x4 kn; kn[0] = pk2(kf[0], kf[1]); kn[1] = pk2(kf[2], kf[3]); kn[2] = pk2(kf[4], kf[5]); kn[3] = pk2(kf[6], kf[7]);
            *(LAS u32x4*)(lds + LDS_K + kk * KSTR + sub * 16) = kn;
            *(LAS u32x4*)(lds + LDS_V + kk * KSTR + sub * 16) = vraw[it];
            if (a.cache && kk >= a.cache_lo) {
                float* cp = a.cache + (long)(kk - a.cache_lo) * a.cstep + sub * 8;
                __builtin_nontemporal_store((f32x4){kf[0], kf[1], kf[2], kf[3]}, (f32x4*)cp); __builtin_nontemporal_store((f32x4){kf[4], kf[5], kf[6], kf[7]}, (f32x4*)(cp + 4));
                __builtin_nontemporal_store((f32x4){bflo(vraw[it][0]), bfhi(vraw[it][0]), bflo(vraw[it][1]), bfhi(vraw[it][1])}, (f32x4*)(cp + 512));
                __builtin_nontemporal_store((f32x4){bflo(vraw[it][2]), bfhi(vraw[it][2]), bflo(vraw[it][3]), bfhi(vraw[it][3])}, (f32x4*)(cp + 516));
            }
        }
    }
    bf16x8 qf[4];
    {   float ss = 0.f;
#pragma unroll
        for (int ks = 0; ks < 4; ++ks) {
#pragma unroll
            for (int e = 0; e < 4; ++e) { const float lo = bflo(qraw[ks][e]), hi = bfhi(qraw[ks][e]); ss += lo * lo + hi * hi; } }
        ss += __shfl_xor(ss, 16); ss += __shfl_xor(ss, 32);
        const float rs = rsqrtf(ss * (1.f / 128.f) + EPS) * (ATTN_SCALE * 1.4426950408889634f);
#pragma unroll
        for (int ks = 0; ks < 4; ++ks) { const f32x4 g0 = *(const f32x4*)(a.qgain + 32 * ks + 8 * kq), g1 = *(const f32x4*)(a.qgain + 32 * ks + 8 * kq + 4);
            u32x4 o; o[0] = pk2(bflo(qraw[ks][0]) * rs * g0[0], bfhi(qraw[ks][0]) * rs * g0[1]); o[1] = pk2(bflo(qraw[ks][1]) * rs * g0[2], bfhi(qraw[ks][1]) * rs * g0[3]);
            o[2] = pk2(bflo(qraw[ks][2]) * rs * g1[0], bfhi(qraw[ks][2]) * rs * g1[1]); o[3] = pk2(bflo(qraw[ks][3]) * rs * g1[2], bfhi(qraw[ks][3]) * rs * g1[3]);
            qf[ks] = __builtin_bit_cast(bf16x8, o); }
    }
    __syncthreads();
    const int kp0 = a.band ? (wid >> 1) : 0;
    const int kpa = (a.band && a.kzero && kp0 < 4) ? 4 : kp0, kp1 = a.band ? kp0 + 5 : 8;
    f32x4 sacc[16];
#pragma unroll
    for (int kp = 0; kp < 8; ++kp)
#pragma unroll
        for (int t = 0; t < 2; ++t) {
            const int krow = 32 * kp + 8 * (qi >> 2) + 4 * t + (qi & 3);
            f32x4 acc = (f32x4){0.f, 0.f, 0.f, 0.f};
            if (kp >= kpa && kp < kp1)
            { bf16x8 kfr[4];
#pragma unroll
            for (int ks = 0; ks < 4; ++ks) kfr[ks] = *(const LAS bf16x8*)(lds + LDS_K + krow * KSTR + (32 * ks + 8 * kq) * 2);
            __builtin_amdgcn_s_setprio(1);
#pragma unroll
            for (int ks = 0; ks < 4; ++ks) acc = mfma16(kfr[ks], qf[ks], acc);
            __builtin_amdgcn_s_setprio(0); }
            sacc[2 * kp + t] = acc;
            __builtin_amdgcn_sched_barrier(0);
        }
    const int iq = 16 * wid + qi;
    float m = -INFINITY;
#pragma unroll
    for (int kp = 0; kp < 8; ++kp)
        if (kp >= kpa && kp < kp1) {
            if (a.band && (kp == kp0 || kp == kp0 + 4)) {
#pragma unroll
                for (int t = 0; t < 2; ++t)
#pragma unroll
                    for (int j = 0; j < 4; ++j) { const int kk = 32 * kp + 8 * kq + 4 * t + j; const int dist = 128 + iq - kk;
                        if (!(dist >= 0 && dist <= 128)) sacc[2 * kp + t][j] = -INFINITY; }
            }
#pragma unroll
            for (int t = 0; t < 2; ++t) m = fmaxf(m, fmaxf(fmaxf(sacc[2 * kp + t][0], sacc[2 * kp + t][1]), fmaxf(sacc[2 * kp + t][2], sacc[2 * kp + t][3])));
        }
    m = fmaxf(m, __shfl_xor(m, 16)); m = fmaxf(m, __shfl_xor(m, 32));
    float sum = 0.f; bf16x8 pb[8];
#pragma unroll
    for (int kp = 0; kp < 8; ++kp) {
        pb[kp] = (bf16x8){0, 0, 0, 0, 0, 0, 0, 0};
        if (kp >= kpa && kp < kp1) { float pv[8];
#pragma unroll
            for (int t = 0; t < 2; ++t)
#pragma unroll
                for (int j = 0; j < 4; ++j) { const float pe = __builtin_amdgcn_exp2f(sacc[2 * kp + t][j] - m); pv[4 * t + j] = pe; sum += pe; }
            u32x4 o; o[0] = pk2(pv[0], pv[1]); o[1] = pk2(pv[2], pv[3]); o[2] = pk2(pv[4], pv[5]); o[3] = pk2(pv[6], pv[7]);
            pb[kp] = __builtin_bit_cast(bf16x8, o); } }
    sum += __shfl_xor(sum, 16); sum += __shfl_xor(sum, 32);
    f32x4 oacc[8];
#pragma unroll
    for (int dt = 0; dt < 8; ++dt) oacc[dt] = (f32x4){0.f, 0.f, 0.f, 0.f};
    const unsigned vaddr0 = lbase + LDS_V + (8 * kq + ((lane & 15) >> 2)) * KSTR + (lane & 3) * 8;
#pragma unroll
    for (int kp = 0; kp < 8; ++kp) {
        const unsigned va = vaddr0 + kp * 32 * KSTR;
        if (kp >= kpa && kp < kp1)
#pragma unroll
        for (int hf = 0; hf < 2; ++hf) {
            s16x4 r0, r1, r2, r3, r4, r5, r6, r7;
            asm volatile("ds_read_b64_tr_b16 %0, %8\n\tds_read_b64_tr_b16 %1, %8 offset:1088\n\t"
                         "ds_read_b64_tr_b16 %2, %8 offset:32\n\tds_read_b64_tr_b16 %3, %8 offset:1120\n\t"
                         "ds_read_b64_tr_b16 %4, %8 offset:64\n\tds_read_b64_tr_b16 %5, %8 offset:1152\n\t"
                         "ds_read_b64_tr_b16 %6, %8 offset:96\n\tds_read_b64_tr_b16 %7, %8 offset:1184\n\ts_waitcnt lgkmcnt(0)"
                         : "=&v"(r0), "=&v"(r1), "=&v"(r2), "=&v"(r3), "=&v"(r4), "=&v"(r5), "=&v"(r6), "=&v"(r7) : "v"(va + hf * 128) : "memory");
            bf16x8 a0 = __builtin_shufflevector(r0, r1, 0, 1, 2, 3, 4, 5, 6, 7), a1 = __builtin_shufflevector(r2, r3, 0, 1, 2, 3, 4, 5, 6, 7);
            bf16x8 a2 = __builtin_shufflevector(r4, r5, 0, 1, 2, 3, 4, 5, 6, 7), a3 = __builtin_shufflevector(r6, r7, 0, 1, 2, 3, 4, 5, 6, 7);
            __builtin_amdgcn_s_setprio(1);
            oacc[4 * hf + 0] = mfma16(a0, pb[kp], oacc[4 * hf + 0]); oacc[4 * hf + 1] = mfma16(a1, pb[kp], oacc[4 * hf + 1]);
            oacc[4 * hf + 2] = mfma16(a2, pb[kp], oacc[4 * hf + 2]); oacc[4 * hf + 3] = mfma16(a3, pb[kp], oacc[4 * hf + 3]);
            __builtin_amdgcn_s_setprio(0);
            __builtin_amdgcn_sched_barrier(0);
        }
    }
    const float inv = 1.f / sum;
    __syncthreads();
    {   LAS unsigned char* ob = lds + LDS_K;
#pragma unroll
        for (int dt = 0; dt < 8; ++dt) { u32x2 o; o[0] = pk2(oacc[dt][0] * inv, oacc[dt][1] * inv); o[1] = pk2(oacc[dt][2] * inv, oacc[dt][3] * inv);
            *(LAS u32x2*)(ob + iq * KSTR + (16 * dt + 4 * kq) * 2) = o; }
        const int ch = lane & 15, rsub = lane >> 4;
        if (a.band) {
#pragma unroll
            for (int it = 0; it < 4; ++it) { const int row = 16 * wid + 4 * it + rsub; const u32x4 v = *(const LAS u32x4*)(ob + row * KSTR + ch * 16);
                *(u32x4*)(a.og + (long)row * a.ogstep + 8 * ch) = v; }
            if (kq == 0) a.lse[(long)iq * a.lsestep] = (m + __log2f(sum)) * 0.6931471805599453f;
        } else {
            u32x4 gv[4];
#pragma unroll
            for (int it = 0; it < 4; ++it) gv[it] = __builtin_nontemporal_load((const u32x4*)(a.gate + (long)(16 * wid + 4 * it + rsub) * INC + 8 * ch));
            asm volatile("" : "+v"(gv[0]), "+v"(gv[1]), "+v"(gv[2]), "+v"(gv[3]));
#pragma unroll
            for (int it = 0; it < 4; ++it) { const int row = 16 * wid + 4 * it + rsub; const u32x4 v = *(const LAS u32x4*)(ob + row * KSTR + ch * 16);
                u32x4 o;
#pragma unroll
                for (int e = 0; e < 4; ++e) o[e] = pk2(silu(bflo(gv[it][e])) * bflo(v[e]), silu(bfhi(gv[it][e])) * bfhi(v[e]));
                *(u32x4*)(a.y + (long)row * LDY + 8 * ch) = o; }
        }
    }
    __syncthreads();
}

constexpr int LDS_PU = 0, LDS_PW = 143 * 128 * 4, LDS_PD = LDS_PW + 128 * KSTR;
DI void pool_item(const Params& p, int l, int tt, int gi, LAS unsigned char* lds) {
    const int tid = opaque_tid(), wid = __builtin_amdgcn_readfirstlane(tid >> 6), lane = tid & 63;
    const unsigned lbase = (unsigned)(uintptr_t)lds;
    const bf16_t* Z = (const bf16_t*)(p.ws + W_Z); bf16_t* Y = (bf16_t*)(p.ws + W_Y);
    const int t0 = tt * 128, pos0 = t0 & (SEQ - 1), b = t0 >> 12, w = 2 << gi;
    LAS float* U = (LAS float*)(lds + LDS_PU);
    {   u32x4 raw[5]; const int sub = lane & 15;
#pragma unroll
        for (int it = 0; it < 5; ++it) { const int row = it * 32 + wid * 4 + (lane >> 4); raw[it] = (u32x4){0u, 0u, 0u, 0u};
            if (row < 143 && pos0 + row - 15 >= 0) raw[it] = *(const u32x4*)(Z + (size_t)(t0 + row - 15) * INC + gi * 128 + sub * 8); }
#pragma unroll
        for (int it = 0; it < 5; ++it) { const int row = it * 32 + wid * 4 + (lane >> 4);
            if (row < 143) { LAS float* up = U + row * 128 + sub * 8;
                *(LAS f32x4*)up = (f32x4){bflo(raw[it][0]), bfhi(raw[it][0]), bflo(raw[it][1]), bfhi(raw[it][1])}; *(LAS f32x4*)(up + 4) = (f32x4){bflo(raw[it][2]), bfhi(raw[it][2]), bflo(raw[it][3]), bfhi(raw[it][3])}; } }
    }
    {   const float* wsrc = p.pool_w + ((size_t)l * 4 + gi) * 16384;
#pragma unroll
        for (int it = 0; it < 4; ++it) { const int idx = it * 512 + tid, c = idx >> 4, ch = idx & 15; const f32x4 v0 = *(const f32x4*)(wsrc + c * 128 + ch * 8), v1 = *(const f32x4*)(wsrc + c * 128 + ch * 8 + 4);
            u32x4 o; o[0] = pk2(v0[0], v0[1]); o[1] = pk2(v0[2], v0[3]); o[2] = pk2(v1[0], v1[1]); o[3] = pk2(v1[2], v1[3]);
            *(LAS u32x4*)(lds + LDS_PW + c * KSTR + ch * 16) = o; } }
    __syncthreads();
    {   const int c4 = (tid & 31) * 4, rg = tid >> 5;
        for (int k = 0; k < 8; ++k) { const int t = rg * 8 + k; f32x4 s = (f32x4){0.f, 0.f, 0.f, 0.f};
            for (int i = 0; i < w; ++i) s += *(const LAS f32x4*)(U + (15 + t - i) * 128 + c4);
            const float ic = 1.f / (float)min(w, pos0 + t + 1); const f32x4 un = *(const LAS f32x4*)(U + (15 + t) * 128 + c4);
            u32x2 o; o[0] = pk2(s[0] * ic - un[0], s[1] * ic - un[1]); o[1] = pk2(s[2] * ic - un[2], s[3] * ic - un[3]);
            *(LAS u32x2*)(lds + LDS_PD + t * KSTR + c4 * 2) = o; }
        if (pos0 == SEQ - 128) { float* sp = p.out + O_SPP + ((size_t)(l * 2 + b) * 15) * 512 + gi * 128;
            for (int e = tid; e < 15 * 128; e += 512) { const int i = e >> 7, c = e & 127; sp[i * 512 + c] = U[(128 + i) * 128 + c]; } }
    }
    __syncthreads();
    const int qi = lane & 15, kq = lane >> 4;
    f32x4 acc[8];
#pragma unroll
    for (int nt = 0; nt < 8; ++nt) acc[nt] = (f32x4){0.f, 0.f, 0.f, 0.f};
    const unsigned waddr0 = lbase + LDS_PW + (8 * kq + ((lane & 15) >> 2)) * KSTR + (lane & 3) * 8;
#pragma unroll
    for (int ks = 0; ks < 4; ++ks) {
        const bf16x8 df = *(const LAS bf16x8*)(lds + LDS_PD + (16 * wid + qi) * KSTR + (32 * ks + 8 * kq) * 2);
        const unsigned va = waddr0 + ks * 32 * KSTR;
#pragma unroll
        for (int hf = 0; hf < 2; ++hf) {
            s16x4 r0, r1, r2, r3, r4, r5, r6, r7;
            asm volatile("ds_read_b64_tr_b16 %0, %8\n\tds_read_b64_tr_b16 %1, %8 offset:1088\n\t"
                         "ds_read_b64_tr_b16 %2, %8 offset:32\n\tds_read_b64_tr_b16 %3, %8 offset:1120\n\t"
                         "ds_read_b64_tr_b16 %4, %8 offset:64\n\tds_read_b64_tr_b16 %5, %8 offset:1152\n\t"
                         "ds_read_b64_tr_b16 %6, %8 offset:96\n\tds_read_b64_tr_b16 %7, %8 offset:1184\n\ts_waitcnt lgkmcnt(0)"
                         : "=&v"(r0), "=&v"(r1), "=&v"(r2), "=&v"(r3), "=&v"(r4), "=&v"(r5), "=&v"(r6), "=&v"(r7) : "v"(va + hf * 128) : "memory");
            bf16x8 a0 = __builtin_shufflevector(r0, r1, 0, 1, 2, 3, 4, 5, 6, 7), a1 = __builtin_shufflevector(r2, r3, 0, 1, 2, 3, 4, 5, 6, 7);
            bf16x8 a2 = __builtin_shufflevector(r4, r5, 0, 1, 2, 3, 4, 5, 6, 7), a3 = __builtin_shufflevector(r6, r7, 0, 1, 2, 3, 4, 5, 6, 7);
            acc[4 * hf + 0] = mfma16(a0, df, acc[4 * hf + 0]); acc[4 * hf + 1] = mfma16(a1, df, acc[4 * hf + 1]);
            acc[4 * hf + 2] = mfma16(a2, df, acc[4 * hf + 2]); acc[4 * hf + 3] = mfma16(a3, df, acc[4 * hf + 3]);
            __builtin_amdgcn_sched_barrier(0);
        }
    }
    {   const int token = t0 + 16 * wid + qi; const float* sc = p.pool_scale + l * 512 + gi * 128 + 4 * kq;
        const bf16_t* gp = Z + (size_t)token * INC + 512 + gi * 128 + 4 * kq; bf16_t* yp = Y + (size_t)token * LDY + gi * 128 + 4 * kq; f32x4 s4a[8]; u32x2 gva[8];
#pragma unroll
        for (int nt = 0; nt < 8; ++nt) { s4a[nt] = *(const f32x4*)(sc + 16 * nt); gva[nt] = *(const u32x2*)(gp + 16 * nt); }
        asm volatile("" : "+v"(gva[0]), "+v"(gva[1]), "+v"(gva[2]), "+v"(gva[3]), "+v"(gva[4]), "+v"(gva[5]), "+v"(gva[6]), "+v"(gva[7]));
        asm volatile("" : "+v"(s4a[0]), "+v"(s4a[1]), "+v"(s4a[2]), "+v"(s4a[3]), "+v"(s4a[4]), "+v"(s4a[5]), "+v"(s4a[6]), "+v"(s4a[7]));
#pragma unroll
        for (int nt = 0; nt < 8; ++nt) { const f32x4 s4 = s4a[nt]; const u32x2 gv = gva[nt];
            u32x2 o; o[0] = pk2(silu(bflo(gv[0])) * acc[nt][0] * s4[0], silu(bfhi(gv[0])) * acc[nt][1] * s4[1]);
            o[1] = pk2(silu(bflo(gv[1])) * acc[nt][2] * s4[2], silu(bfhi(gv[1])) * acc[nt][3] * s4[3]); *(u32x2*)(yp + 16 * nt) = o; } }
    __syncthreads();
}

DI void sample_attn_item(const Params& p, int l, int b, int h, LAS unsigned char* lds) {
    const int tid = opaque_tid(), wid = __builtin_amdgcn_readfirstlane(tid >> 6), lane = tid & 63;
    const float* zs = (const float*)(p.ws + W_ZS) + (size_t)b * INC; float* ys = (float*)(p.ws + W_YS) + (size_t)b * MIXW;
    LAS float* qv = (LAS float*)lds;
    LAS float* knew = qv + 512;
    LAS float* vnew = knew + 384;
    LAS float* sc = vnew + 384;
    LAS float* st = sc + 1024;
    LAS float* red = st + 16;
    if (wid < 7) {
        float v0, v1; const int d0 = lane, d1 = lane + 64;
        if (wid < 3) { const float* s = zs + 1024 + (wid * 3 + 0) * 512 + h * 128; v0 = s[d0]; v1 = s[d1]; }
        else if (wid == 3) { const float* s = zs + 6144 + h * 128; v0 = s[d0]; v1 = s[d1]; }
        else { const float* s = zs + 1024 + ((wid - 4) * 3 + 1) * 512 + h * 128; v0 = s[d0]; v1 = s[d1]; }
        const float ss = wave_sum(v0 * v0 + v1 * v1); const float rs = rsqrtf(ss * (1.f / 128.f) + EPS);
        if (wid < 3) { const float* g = p.dil_q_norm + (l * 3 + wid) * 128; qv[wid * 128 + d0] = v0 * rs * g[d0] * ATTN_SCALE; qv[wid * 128 + d1] = v1 * rs * g[d1] * ATTN_SCALE; }
        else if (wid == 3) { const float* g = p.mem_q_norm + l * 128; qv[384 + d0] = v0 * rs * g[d0] * ATTN_SCALE; qv[384 + d1] = v1 * rs * g[d1] * ATTN_SCALE; }
        else { const int g3 = wid - 4; const float* g = p.dil_k_norm + (l * 3 + g3) * 128; const float k0 = v0 * rs * g[d0], k1 = v1 * rs * g[d1];
            const float* vs = zs + 1024 + (g3 * 3 + 2) * 512 + h * 128; const float w0 = vs[d0], w1 = vs[d1];
            knew[g3 * 128 + d0] = k0; knew[g3 * 128 + d1] = k1; vnew[g3 * 128 + d0] = w0; vnew[g3 * 128 + d1] = w1;
            const int W = 128 << (2 * g3); float* co = p.out + (g3 == 0 ? O_C128S : g3 == 1 ? O_C512S : O_C2048S) + ((size_t)(l * 8 + b) * W + (W - 1)) * 1024 + h * 128;
            co[d0] = k0; co[d1] = k1; co[512 + d0] = w0; co[512 + d1] = w1; }
    }
    __syncthreads();
    {   const int sub = lane & 15;
        for (int c7 = 0; c7 < 3; ++c7) {
            f32x4 k0[7], k1[7];
#pragma unroll
            for (int u = 0; u < 7; ++u) { const int idx = (c7 * 7 + u) * 32 + wid * 4 + (lane >> 4);
                int g, j; if (idx < 396) { g = idx / 132; j = idx % 132; } else { g = 3; j = idx - 396; }
                const bool ok = (g < 3) ? (j < 129) : (j < 256);
                const bool fromc = ok && !(g < 3 && j == 0);
                const int W = 128 << (2 * (g < 3 ? g : 0)), dil = W >> 7; const float* cb = g == 0 ? p.c128 : g == 1 ? p.c512 : g == 2 ? p.c2048 : p.cmem;
                const size_t rowi = !fromc ? 0 : (g < 3 ? (size_t)(l * 8 + b) * W + (W - dil * j) : (size_t)(l * 8 + b) * 256 + j);
                const float* kp = (fromc ? cb : p.cmem) + rowi * 1024 + h * 128;
                k0[u] = *(const f32x4*)(kp + sub * 8); k1[u] = *(const f32x4*)(kp + sub * 8 + 4); }
#pragma unroll
            for (int u = 0; u < 7; ++u) { const int idx = (c7 * 7 + u) * 32 + wid * 4 + (lane >> 4);
                int g, j; if (idx < 396) { g = idx / 132; j = idx % 132; } else { g = 3; j = idx - 396; }
                if (g < 3 && j == 0) { k0[u] = *(const LAS f32x4*)(knew + g * 128 + sub * 8); k1[u] = *(const LAS f32x4*)(knew + g * 128 + sub * 8 + 4); } }
#pragma unroll
            for (int u = 0; u < 7; ++u) { const int idx = (c7 * 7 + u) * 32 + wid * 4 + (lane >> 4);
                int g, j; if (idx < 396) { g = idx / 132; j = idx % 132; } else { g = 3; j = idx - 396; }
                const bool ok = (g < 3) ? (j < 129) : (j < 256);
                const f32x4 q0 = *(const LAS f32x4*)(qv + g * 128 + sub * 8), q1 = *(const LAS f32x4*)(qv + g * 128 + sub * 8 + 4);
                float dot = q0[0] * k0[u][0] + q0[1] * k0[u][1] + q0[2] * k0[u][2] + q0[3] * k0[u][3] + q1[0] * k1[u][0] + q1[1] * k1[u][1] + q1[2] * k1[u][2] + q1[3] * k1[u][3];
                dot = row16_sum(dot);
                if (ok && sub == 0) sc[g * 256 + j] = dot; }
        }
    }
    __syncthreads();
    if (wid < 4) { const int n = wid < 3 ? 129 : 256; float m = -INFINITY;
        for (int j = lane; j < n; j += 64) m = fmaxf(m, sc[wid * 256 + j]);
        m = wave_max(m); float sum = 0.f;
        for (int j = lane; j < n; j += 64) { const float e = __expf(sc[wid * 256 + j] - m); sc[wid * 256 + j] = e; sum += e; }
        sum = wave_sum(sum);
        if (lane == 0) { st[wid * 2] = m + __logf(sum); st[wid * 2 + 1] = 1.f / sum; } }
    __syncthreads();
    {   const int d4 = (tid & 31) * 4, part = tid >> 5;
        f32x4 vv[43];
#pragma unroll
        for (int g = 0; g < 3; ++g) { const int W = 128 << (2 * g), dil = W >> 7; const float* cb = g == 0 ? p.c128 : g == 1 ? p.c512 : p.c2048;
#pragma unroll
            for (int u = 0; u < 9; ++u) { const int j = part + 16 * u; const int jc = (j >= 1 && j < 129) ? j : 1;
                vv[g * 9 + u] = *(const f32x4*)(cb + ((size_t)(l * 8 + b) * W + (W - dil * jc)) * 1024 + 512 + h * 128 + d4); } }
#pragma unroll
        for (int g = 0; g < 3; ++g)
#pragma unroll
            for (int u = 0; u < 9; ++u) { const int j = part + 16 * u;
                if (j == 0) vv[g * 9 + u] = *(const LAS f32x4*)(vnew + g * 128 + d4);
                else if (j >= 129) vv[g * 9 + u] = (f32x4){0.f, 0.f, 0.f, 0.f}; }
#pragma unroll
        for (int u = 0; u < 16; ++u) { const int j = part + 16 * u; vv[27 + u] = *(const f32x4*)(p.cmem + ((size_t)(l * 8 + b) * 256 + j) * 1024 + 512 + h * 128 + d4); }
#pragma unroll
        for (int g = 0; g < 3; ++g) { f32x4 accv = (f32x4){0.f, 0.f, 0.f, 0.f};
#pragma unroll
            for (int u = 0; u < 9; ++u) { const int j = part + 16 * u; if (j < 129) accv += vv[g * 9 + u] * sc[g * 256 + j]; }
            *(LAS f32x4*)(red + (part * 4 + g) * 128 + d4) = accv; }
        {   f32x4 accv = (f32x4){0.f, 0.f, 0.f, 0.f};
#pragma unroll
            for (int u = 0; u < 16; ++u) accv += vv[27 + u] * sc[768 + part + 16 * u];
            *(LAS f32x4*)(red + (part * 4 + 3) * 128 + d4) = accv; }
    }
    __syncthreads();
    {   const int g = tid >> 7, d = tid & 127; float o = 0.f;
#pragma unroll
        for (int part = 0; part < 16; ++part) o += red[(part * 4 + g) * 128 + d];
        o *= st[g * 2 + 1];
        qv[g * 128 + d] = o;
    }
    __syncthreads();
    if (tid < 128) { const int d = tid; const float l0 = st[0], l1 = st[2], l2 = st[4]; const float mm = fmaxf(l0, fmaxf(l1, l2));
        const float e0 = __expf(l0 - mm), e1 = __expf(l1 - mm), e2 = __expf(l2 - mm); const float is = 1.f / (e0 + e1 + e2);
        const float yd = (e0 * qv[d] + e1 * qv[128 + d] + e2 * qv[256 + d]) * is;
        ys[512 + h * 128 + d] = silu(zs[5632 + h * 128 + d]) * yd;
        ys[1024 + h * 128 + d] = silu(zs[6656 + h * 128 + d]) * qv[384 + d]; }
    __syncthreads();
}
DI void sample_pool_item(const Params& p, int l, int b, int gi, LAS unsigned char* lds) {
    const int tid = opaque_tid();
    const float* zs = (const float*)(p.ws + W_ZS) + (size_t)b * INC; float* ys = (float*)(p.ws + W_YS) + (size_t)b * MIXW;
    LAS float* dv = (LAS float*)lds; LAS float* red = dv + 128;
    const float* stp = p.state_pool + ((size_t)(l * 8 + b) * 15) * 512 + gi * 128;
    float* spo = p.out + O_SPS + ((size_t)(l * 8 + b) * 15) * 512 + gi * 128;
    const int w = 2 << gi;
    float pscale = 0.f, pgate = 0.f;
    if (tid < 128) { pscale = p.pool_scale[l * 512 + gi * 128 + tid]; pgate = zs[512 + gi * 128 + tid]; }
    if (tid < 128) { const int c = tid; const float un = zs[gi * 128 + c]; float sv[15];
#pragma unroll
        for (int i = 0; i < 15; ++i) sv[i] = stp[i * 512 + c];
        float s = un;
#pragma unroll
        for (int i = 1; i < 16; ++i) if (i < w) s += sv[15 - i];
        dv[c] = s / (float)w - un;
#pragma unroll
        for (int i = 0; i < 14; ++i) spo[i * 512 + c] = sv[i + 1];
        spo[14 * 512 + c] = un; }
    __syncthreads();
    {   const int d = tid & 127, part = tid >> 7; const float* wp = p.pool_w + ((size_t)l * 4 + gi) * 16384 + d; float s = 0.f; float wv[32];
#pragma unroll
        for (int c = 0; c < 32; ++c) wv[c] = wp[(part * 32 + c) * 128];
#pragma unroll
        for (int c = 0; c < 32; ++c) s += dv[part * 32 + c] * wv[c];
        red[part * 128 + d] = s; }
    __syncthreads();
    if (tid < 128) { const int d = tid; const float o = (red[d] + red[128 + d] + red[256 + d] + red[384 + d]) * pscale;
        ys[gi * 128 + d] = silu(pgate) * o; }
    __syncthreads();
}

template <int K, int LD, int NB>
DI f32x4 gemv16(const LAS unsigned char* xs  , const bf16_t* Wt  , int lane, int ks0, int nks) {
    const int n = lane & 15, kq = lane >> 4;
    const bf16_t* wp = Wt + (size_t)n * LD + kq * 8; const LAS unsigned char* ap = xs + (n & 7) * (2 * K + 16) + kq * 16;
    f32x4 acc = (f32x4){0.f, 0.f, 0.f, 0.f};
    for (int ks = ks0; ks < ks0 + nks; ks += NB) {
        bf16x8 bfr[NB];
#pragma unroll
        for (int u = 0; u < NB; ++u) bfr[u] = __builtin_nontemporal_load((const bf16x8*)(wp + (ks + u) * 32));
#pragma unroll
        for (int u = 0; u < NB; ++u) { const bf16x8 afr = *(const LAS bf16x8*)(ap + (ks + u) * 64); acc = mfma16(afr, bfr[u], acc); }
    }
    return acc;
}

DI void phase_inproj(const Params& p, int l, LAS unsigned char* lds) {
    const int tid = opaque_tid(), wid = __builtin_amdgcn_readfirstlane(tid >> 6), lane = tid & 63, bid = blockIdx.x, G = gridDim.x;
    const bf16_t* WTl = (const bf16_t*)(p.ws + W_WT) + (size_t)l * 8192 * LDA;
    {   pg8::Gemm g; g.A = (const bf16_t*)(p.ws + W_AALL); g.Bt = WTl; g.K = 2048; g.ld = LDA;
        SchedIn S; S.G = G; S.c = bid;
        LAS float* rtab = (LAS float*)(lds + 131072);
        {   const float* ssq = (const float*)(p.ws + W_SSQ); const float* rmem = (const float*)(p.ws + W_RMEM);
            for (int i = 0; i < 4; ++i) { pg8::Unit u;
                if (S.next(i, u) && tid < 256) { const int row = u.pm * 256 + tid; float r;
                    if (u.pm >= 32) r = rmem[row - 8192];
                    else { const f32x4 v0 = *(const f32x4*)(ssq + (size_t)row * 8), v1 = *(const f32x4*)(ssq + (size_t)row * 8 + 4);
                        r = rsqrtf((((v0[0] + v0[1]) + (v0[2] + v0[3])) + ((v1[0] + v1[1]) + (v1[2] + v1[3]))) * (1.f / 2048.f) + EPS); }
                    rtab[i * 256 + tid] = r; } }
            __syncthreads(); }
        EpiIn E; E.z = (bf16_t*)(p.ws + W_Z); E.zmem = (bf16_t*)(p.ws + W_ZMEM); E.rtab = rtab;
        pg8::gemm_phase<EpiIn, SchedIn, GEMM_ALIGN, GEMM_SP2>(lds, g, S, E);
    }
    const int nfull = 904 - 3 * G;
    if (bid >= nfull || G != 256) {
        const int nb = (G != 256) ? G : (G - nfull), b0 = (G != 256) ? bid : (bid - nfull);
        const float* xs = (l == 0) ? p.x_sample : p.out + O_YS;
        LAS float* rs = (LAS float*)(lds + 8 * (2 * 2048 + 16));
        {   const int row = wid; float ss = 0.f; f32x4 xv[8];
#pragma unroll
            for (int it = 0; it < 8; ++it) xv[it] = *(const f32x4*)(xs + row * DM + it * 256 + lane * 4);
#pragma unroll
            for (int it = 0; it < 8; ++it) { const f32x4 v = xv[it]; ss += v[0] * v[0] + v[1] * v[1] + v[2] * v[2] + v[3] * v[3];
                u32x2 o; o[0] = pk2(v[0], v[1]); o[1] = pk2(v[2], v[3]); *(LAS u32x2*)(lds + row * (2 * 2048 + 16) + (it * 256 + lane * 4) * 2) = o; }
            ss = wave_sum(ss); if (lane == 0) rs[row] = rsqrtf(ss * (1.f / 2048.f) + EPS); }
        __syncthreads();
        float* zs = (float*)(p.ws + W_ZS);
        LAS f32x4* red = (LAS f32x4*)(lds + 33024);
        for (int t0 = b0; t0 < 448; t0 += nb * 4) {
            const int task = t0 + nb * (wid >> 1), kh = wid & 1;
            f32x4 acc = (f32x4){0.f, 0.f, 0.f, 0.f};
            if (task < 448) acc = gemv16<2048, LDA, 16>(lds, WTl + (size_t)task * 16 * LDA, lane, 32 * kh, 32);
            red[wid * 64 + lane] = acc;
            __syncthreads();
            if (kh == 0 && task < 448) { acc += red[(wid + 1) * 64 + lane];
                const int n = lane & 15, kq = lane >> 4;
                if (kq < 2) {
#pragma unroll
                    for (int j = 0; j < 4; ++j) { const int row = 4 * kq + j; zs[(size_t)row * INC + task * 16 + n] = acc[j] * rs[row]; } } }
            __syncthreads();
        }
        cache_copy_layer(p, l, b0, nb, 0, NCOPY_TAIL);
        __syncthreads();
        if (l + 1 < DEPTH) { transpose_layer(p, l + 1, 0, NTR_TAIL, b0 * 8 + wid, nb * 8, lds, wid, lane, true); __syncthreads(); }
    }
}

DI void phase_mix(const Params& p, int l, LAS unsigned char* lds) {
    const int bid = blockIdx.x, G = gridDim.x;
    const bf16_t* Z = (const bf16_t*)(p.ws + W_Z); const bf16_t* ZMEM = (const bf16_t*)(p.ws + W_ZMEM);
    for (int item = bid + 64; item < 1344; item += G) {
        if (item < 1088) {
            AttnItem a;
            if (item < 832) {
                const int e = item - 64, g = e >> 8, rem = e & 255, h = rem & 3, b = (rem >> 2) & 1, rem3 = rem >> 3;
                const int dil = 1 << (2 * g), nbq = 32 >> (2 * g), W = 128 * dil, r = rem3 / nbq, j = rem3 % nbq;
                const int qcol = 1024 + (g * 3) * 512 + h * 128;
                a.qb = Z + ((size_t)b * SEQ + (size_t)128 * j * dil + r) * INC + qcol; a.qstep = (long)dil * INC;
                a.kb = Z + ((long)b * SEQ + (long)128 * (j - 1) * dil + r) * INC + qcol + 512; a.kstep = (long)dil * INC;
                a.qgain = p.dil_q_norm + (l * 3 + g) * 128; a.kgain = p.dil_k_norm + (l * 3 + g) * 128;
                a.kzero = (j == 0); a.band = 1;
                a.cache = (j == nbq - 1) ? p.out + (g == 0 ? O_C128P : g == 1 ? O_C512P : O_C2048P) + ((size_t)(l * 2 + b) * W + r) * 1024 + h * 128 : nullptr;
                a.cstep = (long)dil * 1024; a.cache_lo = 128;
                const size_t tok0 = (size_t)b * SEQ + (size_t)128 * j * dil + r;
                a.og = (bf16_t*)(p.ws + W_OG) + ((size_t)g * NTOK + tok0) * 512 + h * 128; a.ogstep = (long)dil * 512;
                a.lse = (float*)(p.ws + W_LSE) + ((size_t)g * NTOK + tok0) * 4 + h; a.lsestep = (long)dil * 4;
                a.y = nullptr; a.gate = nullptr;
            } else {
                const int e = item - 832, h = e & 3, qb = e >> 2, b = qb >> 5;
                a.qb = Z + (size_t)qb * 128 * INC + 6144 + h * 128; a.qstep = INC;
                a.kb = ZMEM + (size_t)b * 256 * 1024 + h * 128; a.kstep = 1024;
                a.qgain = p.mem_q_norm + l * 128; a.kgain = p.mem_k_norm + l * 128;
                a.kzero = 0; a.band = 0;
                a.cache = ((qb & 31) == 0) ? p.out + O_MEMP + ((size_t)(l * 2 + b) * 256) * 1024 + h * 128 : nullptr;
                a.cstep = 1024; a.cache_lo = 0;
                a.og = nullptr; a.ogstep = 0; a.lse = nullptr; a.lsestep = 0;
                a.y = (bf16_t*)(p.ws + W_Y) + (size_t)qb * 128 * LDY + 1024 + h * 128; a.gate = Z + (size_t)qb * 128 * INC + 6656 + h * 128;
            }
#ifndef NO_ATTN
            attn_item(a, lds);
#endif
        } else { const int e = item - 1088;
#ifndef NO_POOL
            pool_item(p, l, e >> 2, e & 3, lds);
#endif
        }
    }
}

DI void phase_combine(const Params& p, int l, LAS unsigned char* lds) {
    const bf16_t* Z = (const bf16_t*)(p.ws + W_Z); const bf16_t* OG = (const bf16_t*)(p.ws + W_OG); const float* LSE = (const float*)(p.ws + W_LSE); bf16_t* Y = (bf16_t*)(p.ws + W_Y);
    const int bid = blockIdx.x, G = gridDim.x;
    if (bid < 64) {
        if (bid < 32) sample_attn_item(p, l, bid >> 2, bid & 3, lds); else sample_pool_item(p, l, (bid - 32) >> 2, bid & 3, lds);
        return;
    }
    for (int idx = (bid - 64) * 512 + opaque_tid(); idx < NTOK * 64; idx += (G - 64) * 512) {
        const int token = idx >> 6, c8 = idx & 63, h = c8 >> 4;
        const float l0 = LSE[(size_t)token * 4 + h], l1 = LSE[((size_t)NTOK + token) * 4 + h], l2 = LSE[((size_t)2 * NTOK + token) * 4 + h];
        const float mm = fmaxf(l0, fmaxf(l1, l2)); float e0 = __expf(l0 - mm), e1 = __expf(l1 - mm), e2 = __expf(l2 - mm); const float is = 1.f / (e0 + e1 + e2); e0 *= is; e1 *= is; e2 *= is;
        const u32x4 a0 = __builtin_nontemporal_load((const u32x4*)(OG + (size_t)token * 512 + c8 * 8)), a1 = __builtin_nontemporal_load((const u32x4*)(OG + ((size_t)NTOK + token) * 512 + c8 * 8)), a2 = __builtin_nontemporal_load((const u32x4*)(OG + ((size_t)2 * NTOK + token) * 512 + c8 * 8));
        const u32x4 gv = __builtin_nontemporal_load((const u32x4*)(Z + (size_t)token * INC + 5632 + c8 * 8));
        u32x4 o;
#pragma unroll
        for (int e = 0; e < 4; ++e) { const float lo = e0 * bflo(a0[e]) + e1 * bflo(a1[e]) + e2 * bflo(a2[e]), hi = e0 * bfhi(a0[e]) + e1 * bfhi(a1[e]) + e2 * bfhi(a2[e]);
            o[e] = pk2(silu(bflo(gv[e])) * lo, silu(bfhi(gv[e])) * hi); }
        *(u32x4*)(Y + (size_t)token * LDY + 512 + c8 * 8) = o;
    }
}

DI void phase_outproj(const Params& p, int l, LAS unsigned char* lds) {
    const int tid = opaque_tid(), wid = __builtin_amdgcn_readfirstlane(tid >> 6), lane = tid & 63, bid = blockIdx.x, G = gridDim.x;
    const bf16_t* WOTl = (const bf16_t*)(p.ws + W_WOT) + (size_t)l * 2048 * LDY;
    {   pg8::Gemm g; g.A = (const bf16_t*)(p.ws + W_Y); g.Bt = WOTl; g.K = 1536; g.ld = LDY;
        SchedOut S; S.G = G; S.c = bid;
        LAS float* ssl = (LAS float*)(lds + 131072);
        EpiOut E; E.xin = (l == 0) ? p.x_prompt : nullptr; E.yout = (l == DEPTH - 1) ? p.out + O_YP : nullptr; E.xb = (bf16_t*)(p.ws + W_AALL); E.ssl = ssl;
        pg8::gemm_phase<EpiOut, SchedOut, false, GEMM_SP2>(lds, g, S, E);
        __syncthreads();
        pg8::Unit u;
        if (S.next(0, u) && tid < 256) { const f32x4 v = *(const LAS f32x4*)(ssl + tid * 4); ((float*)(p.ws + W_SSQ))[(size_t)(u.pm * 256 + tid) * 8 + u.pn] = (v[0] + v[1]) + (v[2] + v[3]); }
    }
    if (bid < 128) {
        const float* ysrc = (const float*)(p.ws + W_YS);
        {   const int row = wid; f32x4 yv[6];
#pragma unroll
            for (int it = 0; it < 6; ++it) yv[it] = *(const f32x4*)(ysrc + row * MIXW + it * 256 + lane * 4);
#pragma unroll
            for (int it = 0; it < 6; ++it) { const f32x4 v = yv[it];
                u32x2 o; o[0] = pk2(v[0], v[1]); o[1] = pk2(v[2], v[3]); *(LAS u32x2*)(lds + row * (2 * 1536 + 16) + (it * 256 + lane * 4) * 2) = o; } }
        __syncthreads();
        {   const int task = bid; const f32x4 part = gemv16<1536, LDY, 6>(lds, WOTl + (size_t)task * 16 * LDY, lane, 6 * wid, 6);
            LAS f32x4* red = (LAS f32x4*)(lds + 8 * (2 * 1536 + 16));
            red[wid * 64 + lane] = part;
            __syncthreads();
            if (wid == 0) { f32x4 acc = red[lane];
#pragma unroll
                for (int w = 1; w < 8; ++w) acc += red[w * 64 + lane];
                const int n = lane & 15, kq = lane >> 4; const float* xo = (l == 0) ? p.x_sample : p.out + O_YS; float* xn = p.out + O_YS;
                if (kq < 2) {
#pragma unroll
                    for (int j = 0; j < 4; ++j) { const int row = 4 * kq + j; const size_t o = (size_t)row * DM + task * 16 + n; xn[o] = xo[o] + acc[j]; } } } }
        __syncthreads();
    }
}

#define XB_TMO      128
#define XB_XCNT(j)  (256  + 64 * (j))
#define XB_XSUB(j)  (1280 + 64 * (j))
#define XB_XGEN(j)  (2304 + 64 * (j))
#define XB_TOP      3328
#define XB_TOPGEN   3392
#define XCD_BAR_WORDS 3456
#define XB_SPIN_CAP (1u << 18)

__device__ __forceinline__ unsigned xb_ld(unsigned* p)              { return __hip_atomic_load(p, __ATOMIC_RELAXED, __HIP_MEMORY_SCOPE_AGENT); }
__device__ __forceinline__ unsigned xb_add(unsigned* p, unsigned v) { return __hip_atomic_fetch_add(p, v, __ATOMIC_RELAXED, __HIP_MEMORY_SCOPE_AGENT); }
__device__ __forceinline__ unsigned xb_xcc_id() { return (unsigned)__builtin_amdgcn_s_getreg((3 << 11) | 20) & 0xFu; }
#define XB_SPIN(cond, bar) do { unsigned _sp = 0; while (cond) { __builtin_amdgcn_s_sleep(1); \
    if ((++_sp & 255u) == 0u) { if (xb_ld(&(bar)[XB_TMO])) break; if (_sp > XB_SPIN_CAP) { atomicAdd(&(bar)[XB_TMO], 1u); break; } } } } while (0)

struct XcdBarrier {
    unsigned* bar; unsigned x;
    volatile LAS unsigned* st;
};

__device__ __forceinline__ XcdBarrier xcd_barrier_post(unsigned* bar, volatile LAS unsigned* st) {
    XcdBarrier b; b.bar = bar; b.x = xb_xcc_id(); b.st = st;
    if (threadIdx.x == 0) (void)xb_add(&bar[XB_XCNT(b.x)], 1u);
    return b;
}
__device__ __forceinline__ void xcd_barrier_complete(unsigned* bar, unsigned x, unsigned& nloc, unsigned& nx) {
    const unsigned G = gridDim.x * gridDim.y * gridDim.z;
    unsigned sum, cnt, mine, sp = 0u;
    for (;;) {
        sum = 0u; cnt = 0u; mine = 0u;
        unsigned cv[16];
        {
            const unsigned* cb = bar + XB_XCNT(0);
            asm volatile("global_load_dword %0, %16, off sc1\n\tglobal_load_dword %1, %16, off offset:256 sc1\n\tglobal_load_dword %2, %16, off offset:512 sc1\n\tglobal_load_dword %3, %16, off offset:768 sc1\n\t"
                         "global_load_dword %4, %16, off offset:1024 sc1\n\tglobal_load_dword %5, %16, off offset:1280 sc1\n\tglobal_load_dword %6, %16, off offset:1536 sc1\n\tglobal_load_dword %7, %16, off offset:1792 sc1\n\t"
                         "global_load_dword %8, %16, off offset:2048 sc1\n\tglobal_load_dword %9, %16, off offset:2304 sc1\n\tglobal_load_dword %10, %16, off offset:2560 sc1\n\tglobal_load_dword %11, %16, off offset:2816 sc1\n\t"
                         "global_load_dword %12, %16, off offset:3072 sc1\n\tglobal_load_dword %13, %16, off offset:3328 sc1\n\tglobal_load_dword %14, %16, off offset:3584 sc1\n\tglobal_load_dword %15, %16, off offset:3840 sc1\n\t"
                         "s_waitcnt vmcnt(0)"
                         : "=&v"(cv[0]), "=&v"(cv[1]), "=&v"(cv[2]), "=&v"(cv[3]), "=&v"(cv[4]), "=&v"(cv[5]), "=&v"(cv[6]), "=&v"(cv[7]),
                           "=&v"(cv[8]), "=&v"(cv[9]), "=&v"(cv[10]), "=&v"(cv[11]), "=&v"(cv[12]), "=&v"(cv[13]), "=&v"(cv[14]), "=&v"(cv[15])
                         : "v"(cb) : "memory");
        }
#pragma unroll
        for (unsigned j = 0; j < 16; ++j) { const unsigned c = cv[j]; sum += c; cnt += (c > 0u) ? 1u : 0u; mine = (j == x) ? c : mine; }
        if (sum == G) break;
        __builtin_amdgcn_s_sleep(1);
        if ((++sp & 255u) == 0u) { if (xb_ld(&bar[XB_TMO])) break; if (sp > XB_SPIN_CAP) { atomicAdd(&bar[XB_TMO], 1u); break; } }
    }
    nloc = mine > 0u ? mine : 1u; nx = cnt > 0u ? cnt : 1u;
}

__device__ __forceinline__ void xcd_barrier(const XcdBarrier& b) {
    asm volatile("s_waitcnt vmcnt(0)" ::: "memory");
    __syncthreads();
    if (threadIdx.x == 0) {
        unsigned* bar = b.bar;
        __builtin_amdgcn_s_waitcnt(0);
        unsigned nloc = b.st[0], nx = b.st[1];
        if (nloc == 0u) { xcd_barrier_complete(bar, b.x, nloc, nx); b.st[0] = nloc; b.st[1] = nx; }
        const unsigned old = xb_add(&bar[XB_XSUB(b.x)], 1u);
        const unsigned gen = old / nloc;
        if (old + 1u == (gen + 1u) * nloc) {
            __builtin_amdgcn_fence(__ATOMIC_RELEASE, "agent");
            asm volatile("s_waitcnt vmcnt(0)" ::: "memory");
            const unsigned og = xb_add(&bar[XB_TOP], 1u);
            const unsigned tg = og / nx;
            if (og + 1u == (tg + 1u) * nx) xb_add(&bar[XB_TOPGEN], 1u);
            else XB_SPIN(xb_ld(&bar[XB_TOPGEN]) == tg, bar);
            __builtin_amdgcn_fence(__ATOMIC_ACQUIRE, "agent");
            xb_add(&bar[XB_XGEN(b.x)], 1u);
            asm volatile("s_waitcnt vmcnt(0)" ::: "memory");
        } else {
            XB_SPIN(xb_ld(&bar[XB_XGEN(b.x)]) == gen, bar);
            __builtin_amdgcn_fence(__ATOMIC_ACQUIRE, "agent");
            asm volatile("s_waitcnt vmcnt(0)" ::: "memory");
        }
    }
    __syncthreads();
}

__global__ __launch_bounds__(512, 2) void mega(Params p, int ph_lo, int ph_hi, int coop) {
    extern __shared__ __attribute__((aligned(16))) unsigned char shm[];
    LAS unsigned char* lds = (LAS unsigned char*)shm;
    volatile LAS unsigned* xst = (volatile LAS unsigned*)(lds + (LDS_BYTES - 16));
    if (threadIdx.x < 2) xst[threadIdx.x] = 0u;
    __syncthreads();
    const XcdBarrier xb = xcd_barrier_post((unsigned*)(p.ws + W_BAR), xst);
    for (int ph = ph_lo; ph < ph_hi; ++ph) {
        int reps = 1;
#ifdef PROBE_PHASE
        if (ph == 0 ? (PROBE_PHASE == 0) : (((ph - 1) & 3) + 1 == PROBE_PHASE && (PROBE_PHASE != 4 || ph == 4))) reps = 2;
#endif
        for (int rep = 0; rep < reps; ++rep) {
            if (ph == 0) prep_phase(p, lds);
            else { const int l = (ph - 1) >> 2, s = (ph - 1) & 3;
                if (s == 0) phase_inproj(p, l, lds);
                else if (s == 1) phase_mix(p, l, lds);
                else if (s == 2) phase_combine(p, l, lds);
                else phase_outproj(p, l, lds); }
            if (coop && (ph + 1 < ph_hi || rep + 1 < reps)) {
                if (coop > 1) cg::this_grid().sync();
                else xcd_barrier(xb); }
        }
    }
}

extern "C" void kernel_launch(void* const* d_in, const int* in_sizes, int n_in, void* d_out, int out_size, void* d_ws, size_t ws_size, hipStream_t stream) {
    Params p{};
    p.x_prompt = (const float*)d_in[0]; p.x_sample = (const float*)d_in[1]; p.state_pool = (const float*)d_in[2]; p.c128 = (const float*)d_in[3];
    p.c512 = (const float*)d_in[4]; p.c2048 = (const float*)d_in[5]; p.cmem = (const float*)d_in[6]; p.mem_prompt = (const float*)d_in[7];
    p.norm_g = (const float*)d_in[8]; p.w_in = (const float*)d_in[9]; p.pool_w = (const float*)d_in[10]; p.pool_scale = (const float*)d_in[11];
    p.dil_q_norm = (const float*)d_in[12]; p.dil_k_norm = (const float*)d_in[13]; p.mem_norm_g = (const float*)d_in[14]; p.w_mem_kv = (const float*)d_in[15];
    p.mem_q_norm = (const float*)d_in[16]; p.mem_k_norm = (const float*)d_in[17]; p.w_out = (const float*)d_in[18];
    p.out = (float*)d_out; p.ws = (unsigned char*)d_ws;
    (void)hipFuncSetAttribute((const void*)mega, hipFuncAttributeMaxDynamicSharedMemorySize, LDS_BYTES);
    static int grid = 0;
    if (!grid) {
        int dev = 0, cus = 0, per_cu = 0;
        (void)hipGetDevice(&dev);
        (void)hipDeviceGetAttribute(&cus, hipDeviceAttributeMultiprocessorCount, dev);
        (void)hipOccupancyMaxActiveBlocksPerMultiprocessor(&per_cu, (const void*)mega, 512, LDS_BYTES);
        if (per_cu < 1) per_cu = 1;
        if (per_cu > 1) per_cu = 1;
        grid = cus * per_cu;
        if (grid > 256) grid = 256;
    }
    (void)hipMemsetAsync((unsigned char*)d_ws + W_BAR, 0, 16384, stream);
    int ph_lo = 0, ph_hi = NPHASE, coop = 1;
    void* args[] = {&p, &ph_lo, &ph_hi, &coop};
    hipError_t e = hipLaunchCooperativeKernel((const void*)mega, dim3(grid), dim3(512), args, LDS_BYTES, stream);
    if (e != hipSuccess) fprintf(stderr, "cooperative launch failed: %s (grid %d)\n", hipGetErrorString(e), grid);
}
```

```cpp
#include <hip/hip_runtime.h>
#include <hip/hip_cooperative_groups.h>
#include <cstdio>
#include <cstdint>
namespace cg = cooperative_groups;

#define LAS __attribute__((address_space(3)))
#define DI __device__ __forceinline__
typedef unsigned short bf16_t;
typedef short bf16x8 __attribute__((ext_vector_type(8)));
typedef short s16x4 __attribute__((ext_vector_type(4)));
typedef float f32x4 __attribute__((ext_vector_type(4)));
typedef unsigned u32x4 __attribute__((ext_vector_type(4)));
typedef unsigned u32x2 __attribute__((ext_vector_type(2)));

constexpr int DM = 2048, SEQ = 4096, NTOK = 8192, DEPTH = 4, SBATCH = 8, INC = 7168, MIXW = 1536;
constexpr int LDA = 2048 + 128;
constexpr int LDY = 1536 + 128;
constexpr int NMEM = 512;
constexpr float EPS = 1e-6f;
constexpr float ATTN_SCALE = 0.08838834764831845f;
constexpr int LDS_BYTES = 147456;
constexpr int NPHASE = 1 + 4 * DEPTH;

constexpr size_t O_YP = 0;
constexpr size_t O_YS = O_YP + (size_t)2 * 4096 * 2048;
constexpr size_t O_SPP = O_YS + (size_t)8 * 2048;
constexpr size_t O_C128P = O_SPP + (size_t)4 * 2 * 15 * 512;
constexpr size_t O_C512P = O_C128P + (size_t)4 * 2 * 128 * 1024;
constexpr size_t O_C2048P = O_C512P + (size_t)4 * 2 * 512 * 1024;
constexpr size_t O_MEMP = O_C2048P + (size_t)4 * 2 * 2048 * 1024;
constexpr size_t O_SPS = O_MEMP + (size_t)4 * 2 * 256 * 1024;
constexpr size_t O_C128S = O_SPS + (size_t)4 * 8 * 15 * 512;
constexpr size_t O_C512S = O_C128S + (size_t)4 * 8 * 128 * 1024;
constexpr size_t O_C2048S = O_C512S + (size_t)4 * 8 * 512 * 1024;

constexpr size_t W_WT = 0;
constexpr size_t W_WOT = W_WT + (size_t)4 * 8192 * LDA * 2;
constexpr size_t W_AALL = W_WOT + (size_t)4 * 2048 * LDY * 2;
constexpr size_t W_Z = W_AALL + (size_t)8704 * LDA * 2;
constexpr size_t W_ZMEM = W_Z + (size_t)8192 * 7168 * 2;
constexpr size_t W_Y = W_ZMEM + (size_t)512 * 1024 * 2;
constexpr size_t W_OG = W_Y + (size_t)8192 * LDY * 2;
constexpr size_t W_LSE = W_OG + (size_t)3 * 8192 * 512 * 2;
constexpr size_t W_SSQ = W_LSE + (size_t)3 * 8192 * 4 * 4;
constexpr size_t W_RMEM = W_SSQ + (size_t)8192 * 32 * 4;
constexpr size_t W_ZS = W_RMEM + 4096;
constexpr size_t W_YS = W_ZS + (size_t)8 * 7168 * 4;
constexpr size_t W_BAR = W_YS + (size_t)8 * 1536 * 4;
constexpr size_t W_END = W_BAR + 16384;

struct Params {
    const float *x_prompt, *x_sample, *state_pool, *c128, *c512, *c2048, *cmem, *mem_prompt, *norm_g, *w_in, *pool_w, *pool_scale,
        *dil_q_norm, *dil_k_norm, *mem_norm_g, *w_mem_kv, *mem_q_norm, *mem_k_norm, *w_out;
    float* out;
    unsigned char* ws;
};

DI unsigned short f2bf(float f) { unsigned u = __float_as_uint(f); u += 0x7fffu + ((u >> 16) & 1u); return (unsigned short)(u >> 16); }
typedef __bf16 hbf16x2 __attribute__((ext_vector_type(2)));
typedef float f32x2 __attribute__((ext_vector_type(2)));
DI unsigned pk2(float lo, float hi) { const f32x2 f = {lo, hi}; return __builtin_bit_cast(unsigned, __builtin_convertvector(f, hbf16x2)); }
DI float bf2f(unsigned short b) { return __uint_as_float(((unsigned)b) << 16); }
DI float bflo(unsigned u) { return __uint_as_float(u << 16); }
DI float bfhi(unsigned u) { return __uint_as_float(u & 0xffff0000u); }
DI float silu(float x) { return x / (1.f + __expf(-x)); }
DI float wave_sum(float v) {
#pragma unroll
    for (int o = 32; o >= 1; o >>= 1) v += __shfl_xor(v, o);
    return v;
}
DI float dpp_add(float v, const int ctrl_is) { return v; }
DI float row16_sum(float v) {
    v += __builtin_bit_cast(float, __builtin_amdgcn_update_dpp(0, __builtin_bit_cast(int, v), 0xB1, 0xF, 0xF, true));
    v += __builtin_bit_cast(float, __builtin_amdgcn_update_dpp(0, __builtin_bit_cast(int, v), 0x4E, 0xF, 0xF, true));
    v += __builtin_bit_cast(float, __builtin_amdgcn_update_dpp(0, __builtin_bit_cast(int, v), 0x141, 0xF, 0xF, true));
    v += __builtin_bit_cast(float, __builtin_amdgcn_update_dpp(0, __builtin_bit_cast(int, v), 0x140, 0xF, 0xF, true));
    return v;
}
DI float wave_max(float v) {
#pragma unroll
    for (int o = 32; o >= 1; o >>= 1) v = fmaxf(v, __shfl_xor(v, o));
    return v;
}
DI int opaque_tid() { int t = threadIdx.x; asm volatile("" : "+v"(t)); return t; }
DI f32x4 mfma16(bf16x8 a, bf16x8 b, f32x4 c) { return __builtin_amdgcn_mfma_f32_16x16x32_bf16(a, b, c, 0, 0, 0); }

namespace pg8 {
constexpr int BM = 256, BK = 64, HALF = 128, HTB = HALF * BK * 2, STAGE_BYTES = 8 * HTB, NXCD = 8, WGM = 8;
DI int lds_byte(int r, int c) { const int st = (r >> 4) * 2 + (c >> 5), rr = r & 15, cc = c & 31, ob = rr * 64 + cc * 2; return st * 1024 + (ob ^ (((ob >> 9) & 1) << 5)); }
DI void stage_rc(int b, int& R, int& C) { const int st = b / 1024, sb = b % 1024, swz = sb ^ (((sb >> 9) & 1) << 5); R = (st >> 1) * 16 + swz / 64; C = (st & 1) * 32 + (swz % 64) / 2; }
DI int perm32(int rho) { const int n = rho >> 4, i = rho & 15; return 8 * (i >> 2) + 4 * n + (i & 3); }
struct Unit { int pm, pn; };
struct Gemm { const bf16_t* A; const bf16_t* Bt; int K, ld; };

DI bool static_unit(int L, int nM, int nN, Unit& u) {
    const int nwg = nM * nN;
    int wgid = L; { const int q = nwg / NXCD, r = nwg % NXCD, xcd = wgid % NXCD, off = wgid / NXCD; wgid = (xcd < r ? xcd * (q + 1) : r * (q + 1) + (xcd - r) * q) + off; }
    const int nig = WGM * nN, gid = wgid / nig, fm = gid * WGM, gsz = (nM - fm) < WGM ? (nM - fm) : WGM;
    u.pm = fm + ((wgid % nig) % gsz); u.pn = (wgid % nig) / gsz; return true;
}

template <class Epi, class Sched, bool ALIGN_EPI, bool SP2>
DI void gemm_phase(LAS unsigned char* lds, const Gemm g, const Sched& S, const Epi& E) {
    const int tid = opaque_tid(), wid = __builtin_amdgcn_readfirstlane(tid >> 6), lane = tid & 63, wr = wid >> 2, wc = wid & 3, fr = lane & 15, fq = lane >> 4;
    const int K = g.K, nt = K / BK, ld = g.ld;
    unsigned voffA[2], voffB[2];
#pragma unroll
    for (int i = 0; i < 2; ++i) { int R, C; stage_rc(tid * 16 + i * 8192, R, C); const int Rb = (R & ~31) + perm32(R & 31);
        voffA[i] = (unsigned)(R * ld + C) * 2u; voffB[i] = (unsigned)(Rb * ld + C) * 2u; }
    const size_t kstep = (size_t)(BK * 2);
    const size_t hstep = (size_t)HALF * ld * 2;
    const size_t tstep = 2 * hstep;
    const unsigned ldsw = (unsigned)wid * 1024u;
    const int aoff = lds_byte(wr * 64 + fr, fq * 8), boff = lds_byte(wc * 32 + fr, fq * 8);
#define PG8_SA(b, h) (((b) * 2 + (h)) * HTB)
#define PG8_SB(b, h) ((4 + (b) * 2 + (h)) * HTB)
#define PG8_STAGE(bufoff, gbase, voff) do { _Pragma("unroll") for (int _i = 0; _i < 2; ++_i) \
        __builtin_amdgcn_global_load_lds((const unsigned*)((const char*)(gbase) + (voff)[_i]), (LAS unsigned*)(lds + (bufoff) + ldsw + _i * 8192), 16, 0, 0); } while (0)
#define PG8_LDA(dst, b, h) do { _Pragma("unroll") for (int m = 0; m < 4; ++m) _Pragma("unroll") for (int k = 0; k < 2; ++k) dst[m][k] = *(const LAS bf16x8*)(lds + PG8_SA(b, h) + aoff + m * 2048 + k * 1024); } while (0)
#define PG8_LDB(dst, b, h) do { _Pragma("unroll") for (int n = 0; n < 2; ++n) _Pragma("unroll") for (int k = 0; k < 2; ++k) dst[n][k] = *(const LAS bf16x8*)(lds + PG8_SB(b, h) + boff + n * 2048 + k * 1024); } while (0)
#define PG8_MMA(ai, bj, At, Bt) do { __builtin_amdgcn_s_setprio(1); _Pragma("unroll") for (int m = 0; m < 4; ++m) _Pragma("unroll") for (int n = 0; n < 2; ++n) _Pragma("unroll") for (int k = 0; k < 2; ++k) \
        acc[ai][bj][m][n] = __builtin_amdgcn_mfma_f32_16x16x32_bf16(Bt[n][k], At[m][k], acc[ai][bj][m][n], 0, 0, 0); __builtin_amdgcn_s_setprio(0); } while (0)
#define PG8_WAIT_V(n) asm volatile("s_waitcnt vmcnt(" #n ")" ::: "memory")
#define PG8_WAIT_L(n) asm volatile("s_waitcnt lgkmcnt(" #n ")" ::: "memory")
#define PG8_BAR __builtin_amdgcn_s_barrier()
#define PG8_SCHED __builtin_amdgcn_sched_barrier(0)
    Unit cur, nxt; int ui = 0;
    if (!S.next(0, cur)) return;
    f32x4 acc[2][2][4][2];
#pragma unroll
    for (int a = 0; a < 2; ++a)
#pragma unroll
        for (int b = 0; b < 2; ++b)
#pragma unroll
            for (int m = 0; m < 4; ++m)
#pragma unroll
                for (int n = 0; n < 2; ++n) acc[a][b][m][n] = (f32x4){0.f, 0.f, 0.f, 0.f};
    bf16x8 At[4][2], B0[2][2], B1[2][2];
    const char* cA = (const char*)g.A + (size_t)cur.pm * tstep; const char* cB = (const char*)g.Bt + (size_t)cur.pn * tstep;
    if constexpr (SP2) {
        PG8_STAGE(PG8_SB(0, 0), cB, voffB); PG8_STAGE(PG8_SB(0, 1), cB + hstep, voffB); PG8_STAGE(PG8_SA(0, 0), cA, voffA); PG8_STAGE(PG8_SA(0, 1), cA + hstep, voffA);
        if (wr == 1) PG8_BAR;
        PG8_WAIT_V(2); PG8_BAR;
        PG8_STAGE(PG8_SB(1, 0), cB + kstep, voffB); PG8_STAGE(PG8_SA(1, 0), cA + kstep, voffA); PG8_STAGE(PG8_SB(1, 1), cB + hstep + kstep, voffB);
        PG8_WAIT_V(6); PG8_BAR;
    } else {
        PG8_STAGE(PG8_SB(0, 0), cB, voffB); PG8_STAGE(PG8_SA(0, 0), cA, voffA); PG8_STAGE(PG8_SB(0, 1), cB + hstep, voffB); PG8_STAGE(PG8_SA(0, 1), cA + hstep, voffA);
        if (wr == 1) PG8_BAR;
        PG8_WAIT_V(4); PG8_BAR;
        PG8_STAGE(PG8_SB(1, 0), cB + kstep, voffB); PG8_STAGE(PG8_SA(1, 0), cA + kstep, voffA); PG8_STAGE(PG8_SB(1, 1), cB + hstep + kstep, voffB);
        PG8_WAIT_V(6); PG8_BAR;
    }
    for (;;) {
        const bool has_next = S.next(ui + 1, nxt);
        const char* nA = has_next ? (const char*)g.A + (size_t)nxt.pm * tstep : cA; const char* nB = has_next ? (const char*)g.Bt + (size_t)nxt.pn * tstep : cB;
        for (int t = 0; t < nt; t += 2) {
            const bool last = (t == nt - 2);
            const char* a1 = cA + (size_t)(t + 1) * kstep;
            const char* a2 = last ? nA : cA + (size_t)(t + 2) * kstep; const char* b2 = last ? nB : cB + (size_t)(t + 2) * kstep;
            const char* a3 = a2 + kstep; const char* b3 = b2 + kstep;
            if constexpr (SP2) {
            PG8_LDB(B0, 0, 0); PG8_LDB(B1, 0, 1); PG8_SCHED; PG8_LDA(At, 0, 0); PG8_STAGE(PG8_SA(1, 1), a1 + hstep, voffA);
            PG8_WAIT_V(8); PG8_WAIT_L(0); PG8_BAR; PG8_MMA(0, 0, At, B0); PG8_MMA(0, 1, At, B1); PG8_BAR; PG8_SCHED;
            PG8_LDA(At, 0, 1); PG8_STAGE(PG8_SB(0, 0), b2, voffB); PG8_STAGE(PG8_SB(0, 1), b2 + hstep, voffB); PG8_STAGE(PG8_SA(0, 0), a2, voffA);
            PG8_WAIT_V(8); PG8_WAIT_L(0); PG8_BAR; PG8_MMA(1, 0, At, B0); PG8_MMA(1, 1, At, B1); PG8_BAR; PG8_SCHED;
            PG8_LDB(B0, 1, 0); PG8_LDB(B1, 1, 1); PG8_SCHED; PG8_LDA(At, 1, 0); PG8_STAGE(PG8_SA(0, 1), a2 + hstep, voffA);
            PG8_WAIT_V(8); PG8_WAIT_L(0); PG8_BAR; PG8_MMA(0, 0, At, B0); PG8_MMA(0, 1, At, B1); PG8_BAR; PG8_SCHED;
            PG8_LDA(At, 1, 1); PG8_STAGE(PG8_SB(1, 0), b3, voffB); PG8_STAGE(PG8_SB(1, 1), b3 + hstep, voffB); PG8_STAGE(PG8_SA(1, 0), a3, voffA);
            PG8_WAIT_V(8); PG8_WAIT_L(0); PG8_BAR; PG8_MMA(1, 0, At, B0); PG8_MMA(1, 1, At, B1); PG8_BAR; PG8_SCHED;
            } else {
            PG8_LDB(B0, 0, 0); PG8_SCHED; PG8_LDA(At, 0, 0); PG8_STAGE(PG8_SA(1, 1), a1 + hstep, voffA);
            PG8_WAIT_L(8); PG8_BAR; PG8_WAIT_L(0); PG8_MMA(0, 0, At, B0); PG8_BAR; PG8_SCHED;
            PG8_LDB(B1, 0, 1); PG8_STAGE(PG8_SB(0, 0), b2, voffB);
            PG8_BAR; PG8_WAIT_L(0); PG8_MMA(0, 1, At, B1); PG8_BAR;
            PG8_LDA(At, 0, 1); PG8_STAGE(PG8_SA(0, 0), a2, voffA);
            PG8_BAR; PG8_WAIT_L(0); PG8_MMA(1, 0, At, B0); PG8_BAR; PG8_SCHED;
            PG8_STAGE(PG8_SB(0, 1), b2 + hstep, voffB);
            PG8_WAIT_V(6); PG8_BAR; PG8_MMA(1, 1, At, B1); PG8_BAR;
            PG8_LDB(B0, 1, 0); PG8_SCHED; PG8_LDA(At, 1, 0); PG8_STAGE(PG8_SA(0, 1), a2 + hstep, voffA);
            PG8_WAIT_L(8); PG8_BAR; PG8_WAIT_L(0); PG8_MMA(0, 0, At, B0); PG8_BAR; PG8_SCHED;
            PG8_LDB(B1, 1, 1); PG8_STAGE(PG8_SB(1, 0), b3, voffB);
            PG8_BAR; PG8_WAIT_L(0); PG8_MMA(0, 1, At, B1); PG8_BAR;
            PG8_LDA(At, 1, 1); PG8_STAGE(PG8_SA(1, 0), a3, voffA);
            PG8_BAR; PG8_WAIT_L(0); PG8_MMA(1, 0, At, B0); PG8_BAR; PG8_SCHED;
            PG8_STAGE(PG8_SB(1, 1), b3 + hstep, voffB);
            PG8_WAIT_V(6); PG8_BAR; PG8_MMA(1, 1, At, B1); PG8_BAR;
            }
        }
        if constexpr (ALIGN_EPI) { if (wr == 0) PG8_BAR; }
        E(acc, cur, ui, wr, wc, fr, fq);
        if (!has_next) break;
#pragma unroll
        for (int a = 0; a < 2; ++a)
#pragma unroll
            for (int b = 0; b < 2; ++b)
#pragma unroll
                for (int m = 0; m < 4; ++m)
#pragma unroll
                    for (int n = 0; n < 2; ++n) acc[a][b][m][n] = (f32x4){0.f, 0.f, 0.f, 0.f};
        cur = nxt; cA = nA; cB = nB; ++ui;
        if constexpr (ALIGN_EPI) { if (wr == 1) PG8_BAR; }
    }
    PG8_WAIT_V(0);
    if constexpr (!ALIGN_EPI) { if (wr == 0) PG8_BAR; }
    PG8_BAR;
#undef PG8_SA
#undef PG8_SB
#undef PG8_STAGE
#undef PG8_LDA
#undef PG8_LDB
#undef PG8_MMA
#undef PG8_WAIT_V
#undef PG8_WAIT_L
#undef PG8_BAR
#undef PG8_SCHED
}
}

constexpr bool GEMM_SP2 = true, GEMM_ALIGN = true;
struct SchedIn {
    int G, c;
    DI bool next(int i, pg8::Unit& u) const {
        const int L = i * G + c;
        if (L >= 904) return false;
        if (L >= 896) { const int e = L - 896; u.pm = 32 + (e >> 2); u.pn = 28 + (e & 3); return true; }
        return pg8::static_unit(L, 32, 28, u);
    }
};
struct SchedOut {
    int G, c;
    DI bool next(int i, pg8::Unit& u) const {
        const int L = i * G + c;
        if (L >= 256) return false;
        return pg8::static_unit(L, 32, 8, u);
    }
};
struct EpiIn {
    bf16_t* z; bf16_t* zmem; const LAS float* rtab;
    DI void operator()(const f32x4 (&acc)[2][2][4][2], const pg8::Unit& u, int ui, int wr, int wc, int fr, int fq) const {
        const bool ismem = u.pm >= 32;
        const int row0 = u.pm * 256 + wr * 64 + fr;
        const int colt = (ismem ? (u.pn - 28) : u.pn) * 256 + wc * 32 + 8 * fq;
        const int ldc = ismem ? 1024 : INC;
        bf16_t* base = ismem ? zmem - (size_t)8192 * 1024 : z;
#pragma unroll
        for (int ai = 0; ai < 2; ++ai)
#pragma unroll
            for (int m = 0; m < 4; ++m) {
                const int row = row0 + ai * 128 + m * 16;
                const float r = rtab[ui * 256 + wr * 64 + fr + ai * 128 + m * 16];
                bf16_t* rowp = base + (size_t)row * ldc + colt;
#pragma unroll
                for (int bj = 0; bj < 2; ++bj) { const f32x4 v0 = acc[ai][bj][m][0] * r, v1 = acc[ai][bj][m][1] * r;
                    u32x4 o; o[0] = pk2(v0[0], v0[1]); o[1] = pk2(v0[2], v0[3]); o[2] = pk2(v1[0], v1[1]); o[3] = pk2(v1[2], v1[3]);
                    *(u32x4*)(rowp + bj * 128) = o; }
            }
    }
};
struct EpiOut {
    const float* xin;
    float* yout;
    bf16_t* xb; LAS float* ssl;
    DI void operator()(const f32x4 (&acc)[2][2][4][2], const pg8::Unit& u, int ui, int wr, int wc, int fr, int fq) const {
        const int row0 = u.pm * 256 + wr * 64 + fr, col0 = u.pn * 256 + wc * 32 + 8 * fq;
#pragma unroll
        for (int ah = 0; ah < 4; ++ah) {
            const int ai = ah >> 1, mh = ah & 1;
            f32x4 xo[8];
            if (xin) {
#pragma unroll
                for (int mm = 0; mm < 2; ++mm)
#pragma unroll
                    for (int bj = 0; bj < 2; ++bj) { const size_t o = (size_t)(row0 + ai * 128 + (2 * mh + mm) * 16) * DM + col0 + bj * 128;
                        xo[(mm * 2 + bj) * 2] = __builtin_nontemporal_load((const f32x4*)(xin + o)); xo[(mm * 2 + bj) * 2 + 1] = __builtin_nontemporal_load((const f32x4*)(xin + o + 4)); }
                asm volatile("" : "+v"(xo[0]), "+v"(xo[1]), "+v"(xo[2]), "+v"(xo[3]), "+v"(xo[4]), "+v"(xo[5]), "+v"(xo[6]), "+v"(xo[7]));
            } else {
                u32x4 xq[4];
#pragma unroll
                for (int mm = 0; mm < 2; ++mm)
#pragma unroll
                    for (int bj = 0; bj < 2; ++bj) xq[mm * 2 + bj] = *(const u32x4*)(xb + (size_t)(row0 + ai * 128 + (2 * mh + mm) * 16) * LDA + col0 + bj * 128);
                asm volatile("" : "+v"(xq[0]), "+v"(xq[1]), "+v"(xq[2]), "+v"(xq[3]));
#pragma unroll
                for (int q = 0; q < 4; ++q) { xo[2 * q] = (f32x4){bflo(xq[q][0]), bfhi(xq[q][0]), bflo(xq[q][1]), bfhi(xq[q][1])}; xo[2 * q + 1] = (f32x4){bflo(xq[q][2]), bfhi(xq[q][2]), bflo(xq[q][3]), bfhi(xq[q][3])}; }
            }
#pragma unroll
            for (int mm = 0; mm < 2; ++mm) {
                const int m = 2 * mh + mm, row = row0 + ai * 128 + m * 16; float ss = 0.f;
#pragma unroll
                for (int bj = 0; bj < 2; ++bj) {
                    const f32x4 v0 = acc[ai][bj][m][0] + xo[(mm * 2 + bj) * 2], v1 = acc[ai][bj][m][1] + xo[(mm * 2 + bj) * 2 + 1];
                    if (yout) { const size_t o = (size_t)row * DM + col0 + bj * 128;
                        __builtin_nontemporal_store(v0, (f32x4*)(yout + o)); __builtin_nontemporal_store(v1, (f32x4*)(yout + o + 4)); }
                    else { u32x4 pb; pb[0] = pk2(v0[0], v0[1]); pb[1] = pk2(v0[2], v0[3]); pb[2] = pk2(v1[0], v1[1]); pb[3] = pk2(v1[2], v1[3]);
                        *(u32x4*)(xb + (size_t)row * LDA + col0 + bj * 128) = pb; }
                    ss += v0[0] * v0[0] + v0[1] * v0[1] + v0[2] * v0[2] + v0[3] * v0[3] + v1[0] * v1[0] + v1[1] * v1[1] + v1[2] * v1[2] + v1[3] * v1[3]; }
                ss += __shfl_xor(ss, 16); ss += __shfl_xor(ss, 32);
                if (fq == 0) ssl[(ai * 128 + wr * 64 + m * 16 + fr) * 4 + wc] = ss;
            }
        }
    }
};

constexpr int NCOPY_TAIL = 2688;
DI void cache_copy_layer(const Params& p, int l, int first, int stride, int lo, int hi) {
    const int tid = opaque_tid();
    if (lo + first >= hi) return;
    for (int u0 = lo + first; u0 < hi; u0 += 4 * stride) {
        f32x4 v[16]; f32x4* dp[4]; int idx[4][4];
#pragma unroll
        for (int hf = 0; hf < 4; ++hf) {
            const int uu = u0 + hf * stride, u = uu < hi ? uu : u0;
            const int b = u / 336, e = u % 336; int W, c; const float* src; float* dst;
            if (e < 16) { W = 128; c = e; src = p.c128; dst = p.out + O_C128S; }
            else if (e < 80) { W = 512; c = e - 16; src = p.c512; dst = p.out + O_C512S; }
            else { W = 2048; c = e - 80; src = p.c2048; dst = p.out + O_C2048S; }
            const size_t base = (size_t)(l * 8 + b) * W * 1024 + (size_t)c * 8192;
            const int n4 = min(8192, (W - 1) * 1024 - c * 8192) >> 2;
            const f32x4* s4 = (const f32x4*)(src + base + 1024); dp[hf] = (f32x4*)(dst + base);
#pragma unroll
            for (int k = 0; k < 4; ++k) { idx[hf][k] = min(tid + k * 512, n4 - 1); v[hf * 4 + k] = __builtin_nontemporal_load(s4 + idx[hf][k]); }
        }
#pragma unroll
        for (int hf = 0; hf < 4; ++hf)
#pragma unroll
            for (int k = 0; k < 4; ++k) __builtin_nontemporal_store(v[hf * 4 + k], dp[hf] + idx[hf][k]);
    }
}

DI void transpose_tile_w(const float* src, int ldn, const float* gain, bf16_t* dst, int ldk, int k0, int n0, LAS float* tile  , int lane, bool stream) {
    f32x4 v[16]; float gg[16];
    const int c4 = (lane & 15) * 4, rr = lane >> 4;
#pragma unroll
    for (int it = 0; it < 16; ++it) v[it] = __builtin_nontemporal_load((const f32x4*)(src + (size_t)(k0 + it * 4 + rr) * ldn + n0 + c4));
#pragma unroll
    for (int it = 0; it < 16; ++it) gg[it] = 1.f;
    if (gain) {
#pragma unroll
        for (int it = 0; it < 16; ++it) gg[it] = gain[k0 + it * 4 + rr]; }
#pragma unroll
    for (int it = 0; it < 16; ++it) { const int r = it * 4 + rr;
        tile[r * 65 + c4 + 0] = v[it][0] * gg[it]; tile[r * 65 + c4 + 1] = v[it][1] * gg[it]; tile[r * 65 + c4 + 2] = v[it][2] * gg[it]; tile[r * 65 + c4 + 3] = v[it][3] * gg[it]; }
#pragma unroll
    for (int it = 0; it < 8; ++it) { const int n = it * 8 + (lane >> 3), kc = (lane & 7) * 8; float t[8];
#pragma unroll
        for (int e = 0; e < 8; ++e) t[e] = tile[(kc + e) * 65 + n];
        u32x4 o; o[0] = pk2(t[0], t[1]); o[1] = pk2(t[2], t[3]); o[2] = pk2(t[4], t[5]); o[3] = pk2(t[6], t[7]);
        u32x4* dp = (u32x4*)(dst + (size_t)(n0 + n) * ldk + k0 + kc);
        if (stream) __builtin_nontemporal_store(o, dp); else *dp = o; }
}

constexpr int NTR_TAIL = 4864;
DI void transpose_layer(const Params& p, int l, int lo, int hi, int w0, int nw, LAS unsigned char* lds, int wid, int lane, bool stream) {
    bf16_t* WT = (bf16_t*)(p.ws + W_WT); bf16_t* WOT = (bf16_t*)(p.ws + W_WOT);
    LAS float* tile = (LAS float*)lds + wid * (64 * 65);
    for (int r = lo + w0; r < hi; r += nw) {
        if (r < 3584) { const int kt = r / 112, nt = r % 112;
            transpose_tile_w(p.w_in + (size_t)l * DM * INC, INC, p.norm_g + l * DM, WT + (size_t)l * 8192 * LDA, LDA, kt * 64, nt * 64, tile, lane, stream); }
        else if (r < 4096) { const int e = r - 3584, kt = e / 16, nt = e % 16;
            transpose_tile_w(p.w_mem_kv + (size_t)l * DM * 1024, 1024, p.mem_norm_g + l * DM, WT + (size_t)l * 8192 * LDA + (size_t)7168 * LDA, LDA, kt * 64, nt * 64, tile, lane, stream); }
        else { const int e = r - 4096, kt = e / 32, nt = e % 32;
            transpose_tile_w(p.w_out + (size_t)l * MIXW * DM, DM, nullptr, WOT + (size_t)l * 2048 * LDY, LDY, kt * 64, nt * 64, tile, lane, stream); }
    }
}

DI void prep_phase(const Params& p, LAS unsigned char* lds) {
    const int tid = opaque_tid(), wid = __builtin_amdgcn_readfirstlane(tid >> 6), lane = tid & 63, bid = blockIdx.x, G = gridDim.x;
    bf16_t* WT = (bf16_t*)(p.ws + W_WT); bf16_t* WOT = (bf16_t*)(p.ws + W_WOT); bf16_t* AALL = (bf16_t*)(p.ws + W_AALL);
    float* SSQ = (float*)(p.ws + W_SSQ); float* RMEM = (float*)(p.ws + W_RMEM);
    for (int row = bid * 8 + wid; row < NTOK + NMEM; row += G * 8) {
        const float* src = row < NTOK ? p.x_prompt + (size_t)row * DM : p.mem_prompt + (size_t)(row - NTOK) * DM;
        bf16_t* dst = AALL + (size_t)row * LDA; float ss = 0.f; f32x4 xv[8];
#pragma unroll
        for (int it = 0; it < 8; ++it) xv[it] = __builtin_nontemporal_load((const f32x4*)(src + it * 256 + lane * 4));
#pragma unroll
        for (int it = 0; it < 8; ++it) { const f32x4 v = xv[it];
            ss += v[0] * v[0] + v[1] * v[1] + v[2] * v[2] + v[3] * v[3];
            u32x2 o; o[0] = pk2(v[0], v[1]); o[1] = pk2(v[2], v[3]); *(u32x2*)(dst + it * 256 + lane * 4) = o; }
        ss = wave_sum(ss);
        if (row < NTOK) { if (lane < 8) SSQ[(size_t)row * 8 + lane] = lane == 0 ? ss : 0.f; }
        else if (lane == 0) RMEM[row - NTOK] = rsqrtf(ss * (1.f / 2048.f) + EPS);
    }
    transpose_layer(p, 0, 0, G == 256 ? 4096 : 4864, bid * 8 + wid, G * 8, lds, wid, lane, false);
    for (int l = 1; l < DEPTH; ++l) transpose_layer(p, l, NTR_TAIL, 4864, bid * 8 + wid, G * 8, lds, wid, lane, true);
    __syncthreads();
    for (int l = 0; l < DEPTH; ++l) cache_copy_layer(p, l, bid, G, NCOPY_TAIL, 2688);
}

constexpr int KSTR = 272;
constexpr int LDS_K = 0, LDS_V = 256 * KSTR;

DI void tr_read8(unsigned addr, s16x4 (&lo)[4], s16x4 (&hi)[4], int) {}

struct AttnItem {
    const bf16_t* qb; long qstep;
    const bf16_t* kb; long kstep;
    const float* qgain; const float* kgain;
    int kzero;
    int band;
    float* cache; long cstep; int cache_lo;
    bf16_t* og; long ogstep;
    float* lse; long lsestep;
    bf16_t* y; const bf16_t* gate;
};

DI void attn_item(const AttnItem& a, LAS unsigned char* lds) {
    const int tid = opaque_tid(), wid = __builtin_amdgcn_readfirstlane(tid >> 6), lane = tid & 63;
    const unsigned lbase = (unsigned)(uintptr_t)lds;
    const int qi = lane & 15, kq = lane >> 4;
    u32x4 qraw[4];
    {   const bf16_t* qp = a.qb + (long)(16 * wid + qi) * a.qstep + 8 * kq;
#pragma unroll
        for (int ks = 0; ks < 4; ++ks) qraw[ks] = __builtin_nontemporal_load((const u32x4*)(qp + 32 * ks)); }
    {   const int sub = lane & 15; float kg[8];
#pragma unroll
        for (int e = 0; e < 8; ++e) kg[e] = a.kgain[sub * 8 + e];
        u32x4 kraw[8], vraw[8];
#pragma unroll
        for (int it = 0; it < 8; ++it) {
            const int kk = it * 32 + wid * 4 + (lane >> 4);
            kraw[it] = (u32x4){0u, 0u, 0u, 0u}; vraw[it] = (u32x4){0u, 0u, 0u, 0u};
            if (!(a.kzero && it < 4)) { const bf16_t* kp = a.kb + (long)kk * a.kstep + sub * 8; kraw[it] = *(const u32x4*)kp; vraw[it] = *(const u32x4*)(kp + 512); }
        }
#pragma unroll
        for (int it = 0; it < 8; ++it) {
            const int kk = it * 32 + wid * 4 + (lane >> 4);
            float kf[8]; float ss = 0.f;
#pragma unroll
            for (int e = 0; e < 4; ++e) { kf[2 * e] = bflo(kraw[it][e]); kf[2 * e + 1] = bfhi(kraw[it][e]); ss += kf[2 * e] * kf[2 * e] + kf[2 * e + 1] * kf[2 * e + 1]; }
            ss = row16_sum(ss);
            const float rs = rsqrtf(ss * (1.f / 128.f) + EPS);
#pragma unroll
            for (int e = 0; e < 8; ++e) kf[e] *= rs * kg[e];
            u32x4 kn; kn[0] = pk2(kf[0], kf[1]); kn[1] = pk2(kf[2], kf[3]); kn[2] = pk2(kf[4], kf[5]); kn[3] = pk2(kf[6], kf[7]);
            *(LAS u32x4*)(lds + LDS_K + kk * KSTR + sub * 16) = kn;
            *(LAS u32x4*)(lds + LDS_V + kk * KSTR + sub * 16) = vraw[it];
            if (a.cache && kk >= a.cache_lo) {
                float* cp = a.cache + (long)(kk - a.cache_lo) * a.cstep + sub * 8;
                __builtin_nontemporal_store((f32x4){kf[0], kf[1], kf[2], kf[3]}, (f32x4*)cp); __builtin_nontemporal_store((f32x4){kf[4], kf[5], kf[6], kf[7]}, (f32x4*)(cp + 4));
                __builtin_nontemporal_store((f32x4){bflo(vraw[it][0]), bfhi(vraw[it][0]), bflo(vraw[it][1]), bfhi(vraw[it][1])}, (f32x4*)(cp + 512));
                __builtin_nontemporal_store((f32x4){bflo(vraw[it][2]), bfhi(vraw[it][2]), bflo(vraw[it][3]), bfhi(vraw[it][3])}, (f32x4*)(cp + 516));
            }
        }
    }
    bf16x8 qf[4];
    {   float ss = 0.f;
#pragma unroll
        for (int ks = 0; ks < 4; ++ks) {
#pragma unroll
            for (int e = 0; e < 4; ++e) { const float lo = bflo(qraw[ks][e]), hi = bfhi(qraw[ks][e]); ss += lo * lo + hi * hi; } }
        ss += __shfl_xor(ss, 16); ss += __shfl_xor(ss, 32);
        const float rs = rsqrtf(ss * (1.f / 128.f) + EPS) * (ATTN_SCALE * 1.4426950408889634f);
#pragma unroll
        for (int ks = 0; ks < 4; ++ks) { const f32x4 g0 = *(const f32x4*)(a.qgain + 32 * ks + 8 * kq), g1 = *(const f32x4*)(a.qgain + 32 * ks + 8 * kq + 4);
            u32x4 o; o[0] = pk2(bflo(qraw[ks][0]) * rs * g0[0], bfhi(qraw[ks][0]) * rs * g0[1]); o[1] = pk2(bflo(qraw[ks][1]) * rs * g0[2], bfhi(qraw[ks][1]) * rs * g0[3]);
            o[2] = pk2(bflo(qraw[ks][2]) * rs * g1[0], bfhi(qraw[ks][2]) * rs * g1[1]); o[3] = pk2(bflo(qraw[ks][3]) * rs * g1[2], bfhi(qraw[ks][3]) * rs * g1[3]);
            qf[ks] = __builtin_bit_cast(bf16x8, o); }
    }
    __syncthreads();
    const int kp0 = a.band ? (wid >> 1) : 0;
    const int kpa = (a.band && a.kzero && kp0 < 4) ? 4 : kp0, kp1 = a.band ? kp0 + 5 : 8;
    f32x4 sacc[16];
#pragma unroll
    for (int kp = 0; kp < 8; ++kp)
#pragma unroll
        for (int t = 0; t < 2; ++t) {
            const int krow = 32 * kp + 8 * (qi >> 2) + 4 * t + (qi & 3);
            f32x4 acc = (f32x4){0.f, 0.f, 0.f, 0.f};
            if (kp >= kpa && kp < kp1)
            { bf16x8 kfr[4];
#pragma unroll
            for (int ks = 0; ks < 4; ++ks) kfr[ks] = *(const LAS bf16x8*)(lds + LDS_K + krow * KSTR + (32 * ks + 8 * kq) * 2);
            __builtin_amdgcn_s_setprio(1);
#pragma unroll
            for (int ks = 0; ks < 4; ++ks) acc = mfma16(kfr[ks], qf[ks], acc);
            __builtin_amdgcn_s_setprio(0); }
            sacc[2 * kp + t] = acc;
            __builtin_amdgcn_sched_barrier(0);
        }
    const int iq = 16 * wid + qi;
    float m = -INFINITY;
#pragma unroll
    for (int kp = 0; kp < 8; ++kp)
        if (kp >= kpa && kp < kp1) {
            if (a.band && (kp == kp0 || kp == kp0 + 4)) {
#pragma unroll
                for (int t = 0; t < 2; ++t)
#pragma unroll
                    for (int j = 0; j < 4; ++j) { const int kk = 32 * kp + 8 * kq + 4 * t + j; const int dist = 128 + iq - kk;
                        if (!(dist >= 0 && dist <= 128)) sacc[2 * kp + t][j] = -INFINITY; }
            }
#pragma unroll
            for (int t = 0; t < 2; ++t) m = fmaxf(m, fmaxf(fmaxf(sacc[2 * kp + t][0], sacc[2 * kp + t][1]), fmaxf(sacc[2 * kp + t][2], sacc[2 * kp + t][3])));
        }
    m = fmaxf(m, __shfl_xor(m, 16)); m = fmaxf(m, __shfl_xor(m, 32));
    float sum = 0.f; bf16x8 pb[8];
#pragma unroll
    for (int kp = 0; kp < 8; ++kp) {
        pb[kp] = (bf16x8){0, 0, 0, 0, 0, 0, 0, 0};
        if (kp >= kpa && kp < kp1) { float pv[8];
#pragma unroll
            for (int t = 0; t < 2; ++t)
#pragma unroll
                for (int j = 0; j < 4; ++j) { const float pe = __builtin_amdgcn_exp2f(sacc[2 * kp + t][j] - m); pv[4 * t + j] = pe; sum += pe; }
            u32x4 o; o[0] = pk2(pv[0], pv[1]); o[1] = pk2(pv[2], pv[3]); o[2] = pk2(pv[4], pv[5]); o[3] = pk2(pv[6], pv[7]);
            pb[kp] = __builtin_bit_cast(bf16x8, o); } }
    sum += __shfl_xor(sum, 16); sum += __shfl_xor(sum, 32);
    f32x4 oacc[8];
#pragma unroll
    for (int dt = 0; dt < 8; ++dt) oacc[dt] = (f32x4){0.f, 0.f, 0.f, 0.f};
    const unsigned vaddr0 = lbase + LDS_V + (8 * kq + ((lane & 15) >> 2)) * KSTR + (lane & 3) * 8;
#pragma unroll
    for (int kp = 0; kp < 8; ++kp) {
        const unsigned va = vaddr0 + kp * 32 * KSTR;
        if (kp >= kpa && kp < kp1)
#pragma unroll
        for (int hf = 0; hf < 2; ++hf) {
            s16x4 r0, r1, r2, r3, r4, r5, r6, r7;
            asm volatile("ds_read_b64_tr_b16 %0, %8\n\tds_read_b64_tr_b16 %1, %8 offset:1088\n\t"
                         "ds_read_b64_tr_b16 %2, %8 offset:32\n\tds_read_b64_tr_b16 %3, %8 offset:1120\n\t"
                         "ds_read_b64_tr_b16 %4, %8 offset:64\n\tds_read_b64_tr_b16 %5, %8 offset:1152\n\t"
                         "ds_read_b64_tr_b16 %6, %8 offset:96\n\tds_read_b64_tr_b16 %7, %8 offset:1184\n\ts_waitcnt lgkmcnt(0)"
                         : "=&v"(r0), "=&v"(r1), "=&v"(r2), "=&v"(r3), "=&v"(r4), "=&v"(r5), "=&v"(r6), "=&v"(r7) : "v"(va + hf * 128) : "memory");
            bf16x8 a0 = __builtin_shufflevector(r0, r1, 0, 1, 2, 3, 4, 5, 6, 7), a1 = __builtin_shufflevector(r2, r3, 0, 1, 2, 3, 4, 5, 6, 7);
            bf16x8 a2 = __builtin_shufflevector(r4, r5, 0, 1, 2, 3, 4, 5, 6, 7), a3 = __builtin_shufflevector(r6, r7, 0, 1, 2, 3, 4, 5, 6, 7);
            __builtin_amdgcn_s_setprio(1);
            oacc[4 * hf + 0] = mfma16(a0, pb[kp], oacc[4 * hf + 0]); oacc[4 * hf + 1] = mfma16(a1, pb[kp], oacc[4 * hf + 1]);
            oacc[4 * hf + 2] = mfma16(a2, pb[kp], oacc[4 * hf + 2]); oacc[4 * hf + 3] = mfma16(a3, pb[kp], oacc[4 * hf + 3]);
            __builtin_amdgcn_s_setprio(0);
            __builtin_amdgcn_sched_barrier(0);
        }
    }
    const float inv = 1.f / sum;
    __syncthreads();
    {   LAS unsigned char* ob = lds + LDS_K;
#pragma unroll
        for (int dt = 0; dt < 8; ++dt) { u32x2 o; o[0] = pk2(oacc[dt][0] * inv, oacc[dt][1] * inv); o[1] = pk2(oacc[dt][2] * inv, oacc[dt][3] * inv);
            *(LAS u32x2*)(ob + iq * KSTR + (16 * dt + 4 * kq) * 2) = o; }
        const int ch = lane & 15, rsub = lane >> 4;
        if (a.band) {
#pragma unroll
            for (int it = 0; it < 4; ++it) { const int row = 16 * wid + 4 * it + rsub; const u32x4 v = *(const LAS u32x4*)(ob + row * KSTR + ch * 16);
                *(u32x4*)(a.og + (long)row * a.ogstep + 8 * ch) = v; }
            if (kq == 0) a.lse[(long)iq * a.lsestep] = (m + __log2f(sum)) * 0.6931471805599453f;
        } else {
            u32x4 gv[4];
#pragma unroll
            for (int it = 0; it < 4; ++it) gv[it] = __builtin_nontemporal_load((const u32x4*)(a.gate + (long)(16 * wid + 4 * it + rsub) * INC + 8 * ch));
            asm volatile("" : "+v"(gv[0]), "+v"(gv[1]), "+v"(gv[2]), "+v"(gv[3]));
#pragma unroll
            for (int it = 0; it < 4; ++it) { const int row = 16 * wid + 4 * it + rsub; const u32x4 v = *(const LAS u32x4*)(ob + row * KSTR + ch * 16);
                u32x4 o;
#pragma unroll
                for (int e = 0; e < 4; ++e) o[e] = pk2(silu(bflo(gv[it][e])) * bflo(v[e]), silu(bfhi(gv[it][e])) * bfhi(v[e]));
                *(u32x4*)(a.y + (long)row * LDY + 8 * ch) = o; }
        }
    }
    __syncthreads();
}

constexpr int LDS_PU = 0, LDS_PW = 143 * 128 * 4, LDS_PD = LDS_PW + 128 * KSTR;
DI void pool_item(const Params& p, int l, int tt, int gi, LAS unsigned char* lds) {
    const int tid = opaque_tid(), wid = __builtin_amdgcn_readfirstlane(tid >> 6), lane = tid & 63;
    const unsigned lbase = (unsigned)(uintptr_t)lds;
    const bf16_t* Z = (const bf16_t*)(p.ws + W_Z); bf16_t* Y = (bf16_t*)(p.ws + W_Y);
    const int t0 = tt * 128, pos0 = t0 & (SEQ - 1), b = t0 >> 12, w = 2 << gi;
    LAS float* U = (LAS float*)(lds + LDS_PU);
    {   u32x4 raw[5]; const int sub = lane & 15;
#pragma unroll
        for (int it = 0; it < 5; ++it) { const int row = it * 32 + wid * 4 + (lane >> 4); raw[it] = (u32x4){0u, 0u, 0u, 0u};
            if (row < 143 && pos0 + row - 15 >= 0) raw[it] = *(const u32x4*)(Z + (size_t)(t0 + row - 15) * INC + gi * 128 + sub * 8); }
#pragma unroll
        for (int it = 0; it < 5; ++it) { const int row = it * 32 + wid * 4 + (lane >> 4);
            if (row < 143) { LAS float* up = U + row * 128 + sub * 8;
                *(LAS f32x4*)up = (f32x4){bflo(raw[it][0]), bfhi(raw[it][0]), bflo(raw[it][1]), bfhi(raw[it][1])}; *(LAS f32x4*)(up + 4) = (f32x4){bflo(raw[it][2]), bfhi(raw[it][2]), bflo(raw[it][3]), bfhi(raw[it][3])}; } }
    }
    {   const float* wsrc = p.pool_w + ((size_t)l * 4 + gi) * 16384;
#pragma unroll
        for (int it = 0; it < 4; ++it) { const int idx = it * 512 + tid, c = idx >> 4, ch = idx & 15; const f32x4 v0 = *(const f32x4*)(wsrc + c * 128 + ch * 8), v1 = *(const f32x4*)(wsrc + c * 128 + ch * 8 + 4);
            u32x4 o; o[0] = pk2(v0[0], v0[1]); o[1] = pk2(v0[2], v0[3]); o[2] = pk2(v1[0], v1[1]); o[3] = pk2(v1[2], v1[3]);
            *(LAS u32x4*)(lds + LDS_PW + c * KSTR + ch * 16) = o; } }
    __syncthreads();
    {   const int c4 = (tid & 31) * 4, rg = tid >> 5;
        for (int k = 0; k < 8; ++k) { const int t = rg * 8 + k; f32x4 s = (f32x4){0.f, 0.f, 0.f, 0.f};
            for (int i = 0; i < w; ++i) s += *(const LAS f32x4*)(U + (15 + t - i) * 128 + c4);
            const float ic = 1.f / (float)min(w, pos0 + t + 1); const f32x4 un = *(const LAS f32x4*)(U + (15 + t) * 128 + c4);
            u32x2 o; o[0] = pk2(s[0] * ic - un[0], s[1] * ic - un[1]); o[1] = pk2(s[2] * ic - un[2], s[3] * ic - un[3]);
            *(LAS u32x2*)(lds + LDS_PD + t * KSTR + c4 * 2) = o; }
        if (pos0 == SEQ - 128) { float* sp = p.out + O_SPP + ((size_t)(l * 2 + b) * 15) * 512 + gi * 128;
            for (int e = tid; e < 15 * 128; e += 512) { const int i = e >> 7, c = e & 127; sp[i * 512 + c] = U[(128 + i) * 128 + c]; } }
    }
    __syncthreads();
    const int qi = lane & 15, kq = lane >> 4;
    f32x4 acc[8];
#pragma unroll
    for (int nt = 0; nt < 8; ++nt) acc[nt] = (f32x4){0.f, 0.f, 0.f, 0.f};
    const unsigned waddr0 = lbase + LDS_PW + (8 * kq + ((lane & 15) >> 2)) * KSTR + (lane & 3) * 8;
#pragma unroll
    for (int ks = 0; ks < 4; ++ks) {
        const bf16x8 df = *(const LAS bf16x8*)(lds + LDS_PD + (16 * wid + qi) * KSTR + (32 * ks + 8 * kq) * 2);
        const unsigned va = waddr0 + ks * 32 * KSTR;
#pragma unroll
        for (int hf = 0; hf < 2; ++hf) {
            s16x4 r0, r1, r2, r3, r4, r5, r6, r7;
            asm volatile("ds_read_b64_tr_b16 %0, %8\n\tds_read_b64_tr_b16 %1, %8 offset:1088\n\t"
                         "ds_read_b64_tr_b16 %2, %8 offset:32\n\tds_read_b64_tr_b16 %3, %8 offset:1120\n\t"
                         "ds_read_b64_tr_b16 %4, %8 offset:64\n\tds_read_b64_tr_b16 %5, %8 offset:1152\n\t"
                         "ds_read_b64_tr_b16 %6, %8 offset:96\n\tds_read_b64_tr_b16 %7, %8 offset:1184\n\ts_waitcnt lgkmcnt(0)"
                         : "=&v"(r0), "=&v"(r1), "=&v"(r2), "=&v"(r3), "=&v"(r4), "=&v"(r5), "=&v"(r6), "=&v"(r7) : "v"(va + hf * 128) : "memory");
            bf16x8 a0 = __builtin_shufflevector(r0, r1, 0, 1, 2, 3, 4, 5, 6, 7), a1 = __builtin_shufflevector(r2, r3, 0, 1, 2, 3, 4, 5, 6, 7);
            bf16x8 a2 = __builtin_shufflevector(r4, r5, 0, 1, 2, 3, 4, 5, 6, 7), a3 = __builtin_shufflevector(r6, r7, 0, 1, 2, 3, 4, 5, 6, 7);
            acc[4 * hf + 0] = mfma16(a0, df, acc[4 * hf + 0]); acc[4 * hf + 1] = mfma16(a1, df, acc[4 * hf + 1]);
            acc[4 * hf + 2] = mfma16(a2, df, acc[4 * hf + 2]); acc[4 * hf + 3] = mfma16(a3, df, acc[4 * hf + 3]);
            __builtin_amdgcn_sched_barrier(0);
        }
    }
    {   const int token = t0 + 16 * wid + qi; const float* sc = p.pool_scale + l * 512 + gi * 128 + 4 * kq;
        const bf16_t* gp = Z + (size_t)token * INC + 512 + gi * 128 + 4 * kq; bf16_t* yp = Y + (size_t)token * LDY + gi * 128 + 4 * kq; f32x4 s4a[8]; u32x2 gva[8];
#pragma unroll
        for (int nt = 0; nt < 8; ++nt) { s4a[nt] = *(const f32x4*)(sc + 16 * nt); gva[nt] = *(const u32x2*)(gp + 16 * nt); }
        asm volatile("" : "+v"(gva[0]), "+v"(gva[1]), "+v"(gva[2]), "+v"(gva[3]), "+v"(gva[4]), "+v"(gva[5]), "+v"(gva[6]), "+v"(gva[7]));
        asm volatile("" : "+v"(s4a[0]), "+v"(s4a[1]), "+v"(s4a[2]), "+v"(s4a[3]), "+v"(s4a[4]), "+v"(s4a[5]), "+v"(s4a[6]), "+v"(s4a[7]));
#pragma unroll
        for (int nt = 0; nt < 8; ++nt) { const f32x4 s4 = s4a[nt]; const u32x2 gv = gva[nt];
            u32x2 o; o[0] = pk2(silu(bflo(gv[0])) * acc[nt][0] * s4[0], silu(bfhi(gv[0])) * acc[nt][1] * s4[1]);
            o[1] = pk2(silu(bflo(gv[1])) * acc[nt][2] * s4[2], silu(bfhi(gv[1])) * acc[nt][3] * s4[3]); *(u32x2*)(yp + 16 * nt) = o; } }
    __syncthreads();
}

DI void sample_attn_item(const Params& p, int l, int b, int h, LAS unsigned char* lds) {
    const int tid = opaque_tid(), wid = __builtin_amdgcn_readfirstlane(tid >> 6), lane = tid & 63;
    const float* zs = (const float*)(p.ws + W_ZS) + (size_t)b * INC; float* ys = (float*)(p.ws + W_YS) + (size_t)b * MIXW;
    LAS float* qv = (LAS float*)lds;
    LAS float* knew = qv + 512;
    LAS float* vnew = knew + 384;
    LAS float* sc = vnew + 384;
    LAS float* st = sc + 1024;
    LAS float* red = st + 16;
    if (wid < 7) {
        float v0, v1; const int d0 = lane, d1 = lane + 64;
        if (wid < 3) { const float* s = zs + 1024 + (wid * 3 + 0) * 512 + h * 128; v0 = s[d0]; v1 = s[d1]; }
        else if (wid == 3) { const float* s = zs + 6144 + h * 128; v0 = s[d0]; v1 = s[d1]; }
        else { const float* s = zs + 1024 + ((wid - 4) * 3 + 1) * 512 + h * 128; v0 = s[d0]; v1 = s[d1]; }
        const float ss = wave_sum(v0 * v0 + v1 * v1); const float rs = rsqrtf(ss * (1.f / 128.f) + EPS);
        if (wid < 3) { const float* g = p.dil_q_norm + (l * 3 + wid) * 128; qv[wid * 128 + d0] = v0 * rs * g[d0] * ATTN_SCALE; qv[wid * 128 + d1] = v1 * rs * g[d1] * ATTN_SCALE; }
        else if (wid == 3) { const float* g = p.mem_q_norm + l * 128; qv[384 + d0] = v0 * rs * g[d0] * ATTN_SCALE; qv[384 + d1] = v1 * rs * g[d1] * ATTN_SCALE; }
        else { const int g3 = wid - 4; const float* g = p.dil_k_norm + (l * 3 + g3) * 128; const float k0 = v0 * rs * g[d0], k1 = v1 * rs * g[d1];
            const float* vs = zs + 1024 + (g3 * 3 + 2) * 512 + h * 128; const float w0 = vs[d0], w1 = vs[d1];
            knew[g3 * 128 + d0] = k0; knew[g3 * 128 + d1] = k1; vnew[g3 * 128 + d0] = w0; vnew[g3 * 128 + d1] = w1;
            const int W = 128 << (2 * g3); float* co = p.out + (g3 == 0 ? O_C128S : g3 == 1 ? O_C512S : O_C2048S) + ((size_t)(l * 8 + b) * W + (W - 1)) * 1024 + h * 128;
            co[d0] = k0; co[d1] = k1; co[512 + d0] = w0; co[512 + d1] = w1; }
    }
    __syncthreads();
    {   const int sub = lane & 15;
        for (int c7 = 0; c7 < 3; ++c7) {
            f32x4 k0[7], k1[7];
#pragma unroll
            for (int u = 0; u < 7; ++u) { const int idx = (c7 * 7 + u) * 32 + wid * 4 + (lane >> 4);
                int g, j; if (idx < 396) { g = idx / 132; j = idx % 132; } else { g = 3; j = idx - 396; }
                const bool ok = (g < 3) ? (j < 129) : (j < 256);
                const bool fromc = ok && !(g < 3 && j == 0);
                const int W = 128 << (2 * (g < 3 ? g : 0)), dil = W >> 7; const float* cb = g == 0 ? p.c128 : g == 1 ? p.c512 : g == 2 ? p.c2048 : p.cmem;
                const size_t rowi = !fromc ? 0 : (g < 3 ? (size_t)(l * 8 + b) * W + (W - dil * j) : (size_t)(l * 8 + b) * 256 + j);
                const float* kp = (fromc ? cb : p.cmem) + rowi * 1024 + h * 128;
                k0[u] = *(const f32x4*)(kp + sub * 8); k1[u] = *(const f32x4*)(kp + sub * 8 + 4); }
#pragma unroll
            for (int u = 0; u < 7; ++u) { const int idx = (c7 * 7 + u) * 32 + wid * 4 + (lane >> 4);
                int g, j; if (idx < 396) { g = idx / 132; j = idx % 132; } else { g = 3; j = idx - 396; }
                if (g < 3 && j == 0) { k0[u] = *(const LAS f32x4*)(knew + g * 128 + sub * 8); k1[u] = *(const LAS f32x4*)(knew + g * 128 + sub * 8 + 4); } }
#pragma unroll
            for (int u = 0; u < 7; ++u) { const int idx = (c7 * 7 + u) * 32 + wid * 4 + (lane >> 4);
                int g, j; if (idx < 396) { g = idx / 132; j = idx % 132; } else { g = 3; j = idx - 396; }
                const bool ok = (g < 3) ? (j < 129) : (j < 256);
                const f32x4 q0 = *(const LAS f32x4*)(qv + g * 128 + sub * 8), q1 = *(const LAS f32x4*)(qv + g * 128 + sub * 8 + 4);
                float dot = q0[0] * k0[u][0] + q0[1] * k0[u][1] + q0[2] * k0[u][2] + q0[3] * k0[u][3] + q1[0] * k1[u][0] + q1[1] * k1[u][1] + q1[2] * k1[u][2] + q1[3] * k1[u][3];
                dot = row16_sum(dot);
                if (ok && sub == 0) sc[g * 256 + j] = dot; }
        }
    }
    __syncthreads();
    if (wid < 4) { const int n = wid < 3 ? 129 : 256; float m = -INFINITY;
        for (int j = lane; j < n; j += 64) m = fmaxf(m, sc[wid * 256 + j]);
        m = wave_max(m); float sum = 0.f;
        for (int j = lane; j < n; j += 64) { const float e = __expf(sc[wid * 256 + j] - m); sc[wid * 256 + j] = e; sum += e; }
        sum = wave_sum(sum);
        if (lane == 0) { st[wid * 2] = m + __logf(sum); st[wid * 2 + 1] = 1.f / sum; } }
    __syncthreads();
    {   const int d4 = (tid & 31) * 4, part = tid >> 5;
        f32x4 vv[43];
#pragma unroll
        for (int g = 0; g < 3; ++g) { const int W = 128 << (2 * g), dil = W >> 7; const float* cb = g == 0 ? p.c128 : g == 1 ? p.c512 : p.c2048;
#pragma unroll
            for (int u = 0; u < 9; ++u) { const int j = part + 16 * u; const int jc = (j >= 1 && j < 129) ? j : 1;
                vv[g * 9 + u] = *(const f32x4*)(cb + ((size_t)(l * 8 + b) * W + (W - dil * jc)) * 1024 + 512 + h * 128 + d4); } }
#pragma unroll
        for (int g = 0; g < 3; ++g)
#pragma unroll
            for (int u = 0; u < 9; ++u) { const int j = part + 16 * u;
                if (j == 0) vv[g * 9 + u] = *(const LAS f32x4*)(vnew + g * 128 + d4);
                else if (j >= 129) vv[g * 9 + u] = (f32x4){0.f, 0.f, 0.f, 0.f}; }
#pragma unroll
        for (int u = 0; u < 16; ++u) { const int j = part + 16 * u; vv[27 + u] = *(const f32x4*)(p.cmem + ((size_t)(l * 8 + b) * 256 + j) * 1024 + 512 + h * 128 + d4); }
#pragma unroll
        for (int g = 0; g < 3; ++g) { f32x4 accv = (f32x4){0.f, 0.f, 0.f, 0.f};
#pragma unroll
            for (int u = 0; u < 9; ++u) { const int j = part + 16 * u; if (j < 129) accv += vv[g * 9 + u] * sc[g * 256 + j]; }
            *(LAS f32x4*)(red + (part * 4 + g) * 128 + d4) = accv; }
        {   f32x4 accv = (f32x4){0.f, 0.f, 0.f, 0.f};
#pragma unroll
            for (int u = 0; u < 16; ++u) accv += vv[27 + u] * sc[768 + part + 16 * u];
            *(LAS f32x4*)(red + (part * 4 + 3) * 128 + d4) = accv; }
    }
    __syncthreads();
    {   const int g = tid >> 7, d = tid & 127; float o = 0.f;
#pragma unroll
        for (int part = 0; part < 16; ++part) o += red[(part * 4 + g) * 128 + d];
        o *= st[g * 2 + 1];
        qv[g * 128 + d] = o;
    }
    __syncthreads();
    if (tid < 128) { const int d = tid; const float l0 = st[0], l1 = st[2], l2 = st[4]; const float mm = fmaxf(l0, fmaxf(l1, l2));
        const float e0 = __expf(l0 - mm), e1 = __expf(l1 - mm), e2 = __expf(l2 - mm); const float is = 1.f / (e0 + e1 + e2);
        const float yd = (e0 * qv[d] + e1 * qv[128 + d] + e2 * qv[256 + d]) * is;
        ys[512 + h * 128 + d] = silu(zs[5632 + h * 128 + d]) * yd;
        ys[1024 + h * 128 + d] = silu(zs[6656 + h * 128 + d]) * qv[384 + d]; }
    __syncthreads();
}
DI void sample_pool_item(const Params& p, int l, int b, int gi, LAS unsigned char* lds) {
    const int tid = opaque_tid();
    const float* zs = (const float*)(p.ws + W_ZS) + (size_t)b * INC; float* ys = (float*)(p.ws + W_YS) + (size_t)b * MIXW;
    LAS float* dv = (LAS float*)lds; LAS float* red = dv + 128;
    const float* stp = p.state_pool + ((size_t)(l * 8 + b) * 15) * 512 + gi * 128;
    float* spo = p.out + O_SPS + ((size_t)(l * 8 + b) * 15) * 512 + gi * 128;
    const int w = 2 << gi;
    float pscale = 0.f, pgate = 0.f;
    if (tid < 128) { pscale = p.pool_scale[l * 512 + gi * 128 + tid]; pgate = zs[512 + gi * 128 + tid]; }
    if (tid < 128) { const int c = tid; const float un = zs[gi * 128 + c]; float sv[15];
#pragma unroll
        for (int i = 0; i < 15; ++i) sv[i] = stp[i * 512 + c];
        float s = un;
#pragma unroll
        for (int i = 1; i < 16; ++i) if (i < w) s += sv[15 - i];
        dv[c] = s / (float)w - un;
#pragma unroll
        for (int i = 0; i < 14; ++i) spo[i * 512 + c] = sv[i + 1];
        spo[14 * 512 + c] = un; }
    __syncthreads();
    {   const int d = tid & 127, part = tid >> 7; const float* wp = p.pool_w + ((size_t)l * 4 + gi) * 16384 + d; float s = 0.f; float wv[32];
#pragma unroll
        for (int c = 0; c < 32; ++c) wv[c] = wp[(part * 32 + c) * 128];
#pragma unroll
        for (int c = 0; c < 32; ++c) s += dv[part * 32 + c] * wv[c];
        red[part * 128 + d] = s; }
    __syncthreads();
    if (tid < 128) { const int d = tid; const float o = (red[d] + red[128 + d] + red[256 + d] + red[384 + d]) * pscale;
        ys[gi * 128 + d] = silu(pgate) * o; }
    __syncthreads();
}

template <int K, int LD, int NB>
DI f32x4 gemv16(const LAS unsigned char* xs  , const bf16_t* Wt  , int lane, int ks0, int nks) {
    const int n = lane & 15, kq = lane >> 4;
    const bf16_t* wp = Wt + (size_t)n * LD + kq * 8; const LAS unsigned char* ap = xs + (n & 7) * (2 * K + 16) + kq * 16;
    f32x4 acc = (f32x4){0.f, 0.f, 0.f, 0.f};
    for (int ks = ks0; ks < ks0 + nks; ks += NB) {
        bf16x8 bfr[NB];
#pragma unroll
        for (int u = 0; u < NB; ++u) bfr[u] = __builtin_nontemporal_load((const bf16x8*)(wp + (ks + u) * 32));
#pragma unroll
        for (int u = 0; u < NB; ++u) { const bf16x8 afr = *(const LAS bf16x8*)(ap + (ks + u) * 64); acc = mfma16(afr, bfr[u], acc); }
    }
    return acc;
}

DI void phase_inproj(const Params& p, int l, LAS unsigned char* lds) {
    const int tid = opaque_tid(), wid = __builtin_amdgcn_readfirstlane(tid >> 6), lane = tid & 63, bid = blockIdx.x, G = gridDim.x;
    const bf16_t* WTl = (const bf16_t*)(p.ws + W_WT) + (size_t)l * 8192 * LDA;
    {   pg8::Gemm g; g.A = (const bf16_t*)(p.ws + W_AALL); g.Bt = WTl; g.K = 2048; g.ld = LDA;
        SchedIn S; S.G = G; S.c = bid;
        LAS float* rtab = (LAS float*)(lds + 131072);
        {   const float* ssq = (const float*)(p.ws + W_SSQ); const float* rmem = (const float*)(p.ws + W_RMEM);
            for (int i = 0; i < 4; ++i) { pg8::Unit u;
                if (S.next(i, u) && tid < 256) { const int row = u.pm * 256 + tid; float r;
                    if (u.pm >= 32) r = rmem[row - 8192];
                    else { const f32x4 v0 = *(const f32x4*)(ssq + (size_t)row * 8), v1 = *(const f32x4*)(ssq + (size_t)row * 8 + 4);
                        r = rsqrtf((((v0[0] + v0[1]) + (v0[2] + v0[3])) + ((v1[0] + v1[1]) + (v1[2] + v1[3]))) * (1.f / 2048.f) + EPS); }
                    rtab[i * 256 + tid] = r; } }
            __syncthreads(); }
        EpiIn E; E.z = (bf16_t*)(p.ws + W_Z); E.zmem = (bf16_t*)(p.ws + W_ZMEM); E.rtab = rtab;
        pg8::gemm_phase<EpiIn, SchedIn, GEMM_ALIGN, GEMM_SP2>(lds, g, S, E);
    }
    const int nfull = 904 - 3 * G;
    if (bid >= nfull || G != 256) {
        const int nb = (G != 256) ? G : (G - nfull), b0 = (G != 256) ? bid : (bid - nfull);
        const float* xs = (l == 0) ? p.x_sample : p.out + O_YS;
        LAS float* rs = (LAS float*)(lds + 8 * (2 * 2048 + 16));
        {   const int row = wid; float ss = 0.f; f32x4 xv[8];
#pragma unroll
            for (int it = 0; it < 8; ++it) xv[it] = *(const f32x4*)(xs + row * DM + it * 256 + lane * 4);
#pragma unroll
            for (int it = 0; it < 8; ++it) { const f32x4 v = xv[it]; ss += v[0] * v[0] + v[1] * v[1] + v[2] * v[2] + v[3] * v[3];
                u32x2 o; o[0] = pk2(v[0], v[1]); o[1] = pk2(v[2], v[3]); *(LAS u32x2*)(lds + row * (2 * 2048 + 16) + (it * 256 + lane * 4) * 2) = o; }
            ss = wave_sum(ss); if (lane == 0) rs[row] = rsqrtf(ss * (1.f / 2048.f) + EPS); }
        __syncthreads();
        float* zs = (float*)(p.ws + W_ZS);
        LAS f32x4* red = (LAS f32x4*)(lds + 33024);
        for (int t0 = b0; t0 < 448; t0 += nb * 4) {
            const int task = t0 + nb * (wid >> 1), kh = wid & 1;
            f32x4 acc = (f32x4){0.f, 0.f, 0.f, 0.f};
            if (task < 448) acc = gemv16<2048, LDA, 16>(lds, WTl + (size_t)task * 16 * LDA, lane, 32 * kh, 32);
            red[wid * 64 + lane] = acc;
            __syncthreads();
            if (kh == 0 && task < 448) { acc += red[(wid + 1) * 64 + lane];
                const int n = lane & 15, kq = lane >> 4;
                if (kq < 2) {
#pragma unroll
                    for (int j = 0; j < 4; ++j) { const int row = 4 * kq + j; zs[(size_t)row * INC + task * 16 + n] = acc[j] * rs[row]; } } }
            __syncthreads();
        }
        cache_copy_layer(p, l, b0, nb, 0, NCOPY_TAIL);
        __syncthreads();
        if (l == 0 && G == 256) { transpose_layer(p, 0, 4096, 4864, b0 * 8 + wid, nb * 8, lds, wid, lane, false); __syncthreads(); }
        if (l + 1 < DEPTH) { transpose_layer(p, l + 1, 0, NTR_TAIL, b0 * 8 + wid, nb * 8, lds, wid, lane, true); __syncthreads(); }
    }
}

DI void phase_mix(const Params& p, int l, LAS unsigned char* lds) {
    const int bid = blockIdx.x, G = gridDim.x;
    const bf16_t* Z = (const bf16_t*)(p.ws + W_Z); const bf16_t* ZMEM = (const bf16_t*)(p.ws + W_ZMEM);
    for (int item = bid + 64; item < 1344; item += G) {
        if (item < 1088) {
            AttnItem a;
            if (item < 832) {
                const int e = item - 64, g = e >> 8, rem = e & 255, h = rem & 3, b = (rem >> 2) & 1, rem3 = rem >> 3;
                const int dil = 1 << (2 * g), nbq = 32 >> (2 * g), W = 128 * dil, r = rem3 / nbq, j = rem3 % nbq;
                const int qcol = 1024 + (g * 3) * 512 + h * 128;
                a.qb = Z + ((size_t)b * SEQ + (size_t)128 * j * dil + r) * INC + qcol; a.qstep = (long)dil * INC;
                a.kb = Z + ((long)b * SEQ + (long)128 * (j - 1) * dil + r) * INC + qcol + 512; a.kstep = (long)dil * INC;
                a.qgain = p.dil_q_norm + (l * 3 + g) * 128; a.kgain = p.dil_k_norm + (l * 3 + g) * 128;
                a.kzero = (j == 0); a.band = 1;
                a.cache = (j == nbq - 1) ? p.out + (g == 0 ? O_C128P : g == 1 ? O_C512P : O_C2048P) + ((size_t)(l * 2 + b) * W + r) * 1024 + h * 128 : nullptr;
                a.cstep = (long)dil * 1024; a.cache_lo = 128;
                const size_t tok0 = (size_t)b * SEQ + (size_t)128 * j * dil + r;
                a.og = (bf16_t*)(p.ws + W_OG) + ((size_t)g * NTOK + tok0) * 512 + h * 128; a.ogstep = (long)dil * 512;
                a.lse = (float*)(p.ws + W_LSE) + ((size_t)g * NTOK + tok0) * 4 + h; a.lsestep = (long)dil * 4;
                a.y = nullptr; a.gate = nullptr;
            } else {
                const int e = item - 832, h = e & 3, qb = e >> 2, b = qb >> 5;
                a.qb = Z + (size_t)qb * 128 * INC + 6144 + h * 128; a.qstep = INC;
                a.kb = ZMEM + (size_t)b * 256 * 1024 + h * 128; a.kstep = 1024;
                a.qgain = p.mem_q_norm + l * 128; a.kgain = p.mem_k_norm + l * 128;
                a.kzero = 0; a.band = 0;
                a.cache = ((qb & 31) == 0) ? p.out + O_MEMP + ((size_t)(l * 2 + b) * 256) * 1024 + h * 128 : nullptr;
                a.cstep = 1024; a.cache_lo = 0;
                a.og = nullptr; a.ogstep = 0; a.lse = nullptr; a.lsestep = 0;
                a.y = (bf16_t*)(p.ws + W_Y) + (size_t)qb * 128 * LDY + 1024 + h * 128; a.gate = Z + (size_t)qb * 128 * INC + 6656 + h * 128;
            }
#ifndef NO_ATTN
            attn_item(a, lds);
#endif
        } else { const int e = item - 1088;
#ifndef NO_POOL
            pool_item(p, l, e >> 2, e & 3, lds);
#endif
        }
    }
}

DI void phase_combine(const Params& p, int l, LAS unsigned char* lds) {
    const bf16_t* Z = (const bf16_t*)(p.ws + W_Z); const bf16_t* OG = (const bf16_t*)(p.ws + W_OG); const float* LSE = (const float*)(p.ws + W_LSE); bf16_t* Y = (bf16_t*)(p.ws + W_Y);
    const int bid = blockIdx.x, G = gridDim.x;
    if (bid < 64) {
        if (bid < 32) sample_attn_item(p, l, bid >> 2, bid & 3, lds); else sample_pool_item(p, l, (bid - 32) >> 2, bid & 3, lds);
        return;
    }
    for (int idx = (bid - 64) * 512 + opaque_tid(); idx < NTOK * 64; idx += (G - 64) * 512) {
        const int token = idx >> 6, c8 = idx & 63, h = c8 >> 4;
        const float l0 = LSE[(size_t)token * 4 + h], l1 = LSE[((size_t)NTOK + token) * 4 + h], l2 = LSE[((size_t)2 * NTOK + token) * 4 + h];
        const float mm = fmaxf(l0, fmaxf(l1, l2)); float e0 = __expf(l0 - mm), e1 = __expf(l1 - mm), e2 = __expf(l2 - mm); const float is = 1.f / (e0 + e1 + e2); e0 *= is; e1 *= is; e2 *= is;
        const u32x4 a0 = __builtin_nontemporal_load((const u32x4*)(OG + (size_t)token * 512 + c8 * 8)), a1 = __builtin_nontemporal_load((const u32x4*)(OG + ((size_t)NTOK + token) * 512 + c8 * 8)), a2 = __builtin_nontemporal_load((const u32x4*)(OG + ((size_t)2 * NTOK + token) * 512 + c8 * 8));
        const u32x4 gv = __builtin_nontemporal_load((const u32x4*)(Z + (size_t)token * INC + 5632 + c8 * 8));
        u32x4 o;
#pragma unroll
        for (int e = 0; e < 4; ++e) { const float lo = e0 * bflo(a0[e]) + e1 * bflo(a1[e]) + e2 * bflo(a2[e]), hi = e0 * bfhi(a0[e]) + e1 * bfhi(a1[e]) + e2 * bfhi(a2[e]);
            o[e] = pk2(silu(bflo(gv[e])) * lo, silu(bfhi(gv[e])) * hi); }
        *(u32x4*)(Y + (size_t)token * LDY + 512 + c8 * 8) = o;
    }
}

DI void phase_outproj(const Params& p, int l, LAS unsigned char* lds) {
    const int tid = opaque_tid(), wid = __builtin_amdgcn_readfirstlane(tid >> 6), lane = tid & 63, bid = blockIdx.x, G = gridDim.x;
    const bf16_t* WOTl = (const bf16_t*)(p.ws + W_WOT) + (size_t)l * 2048 * LDY;
    {   pg8::Gemm g; g.A = (const bf16_t*)(p.ws + W_Y); g.Bt = WOTl; g.K = 1536; g.ld = LDY;
        SchedOut S; S.G = G; S.c = bid;
        LAS float* ssl = (LAS float*)(lds + 131072);
        EpiOut E; E.xin = (l == 0) ? p.x_prompt : nullptr; E.yout = (l == DEPTH - 1) ? p.out + O_YP : nullptr; E.xb = (bf16_t*)(p.ws + W_AALL); E.ssl = ssl;
        pg8::gemm_phase<EpiOut, SchedOut, false, GEMM_SP2>(lds, g, S, E);
        __syncthreads();
        pg8::Unit u;
        if (S.next(0, u) && tid < 256) { const f32x4 v = *(const LAS f32x4*)(ssl + tid * 4); ((float*)(p.ws + W_SSQ))[(size_t)(u.pm * 256 + tid) * 8 + u.pn] = (v[0] + v[1]) + (v[2] + v[3]); }
    }
    if (bid < 128) {
        const float* ysrc = (const float*)(p.ws + W_YS);
        {   const int row = wid; f32x4 yv[6];
#pragma unroll
            for (int it = 0; it < 6; ++it) yv[it] = *(const f32x4*)(ysrc + row * MIXW + it * 256 + lane * 4);
#pragma unroll
            for (int it = 0; it < 6; ++it) { const f32x4 v = yv[it];
                u32x2 o; o[0] = pk2(v[0], v[1]); o[1] = pk2(v[2], v[3]); *(LAS u32x2*)(lds + row * (2 * 1536 + 16) + (it * 256 + lane * 4) * 2) = o; } }
        __syncthreads();
        {   const int task = bid; const f32x4 part = gemv16<1536, LDY, 6>(lds, WOTl + (size_t)task * 16 * LDY, lane, 6 * wid, 6);
            LAS f32x4* red = (LAS f32x4*)(lds + 8 * (2 * 1536 + 16));
            red[wid * 64 + lane] = part;
            __syncthreads();
            if (wid == 0) { f32x4 acc = red[lane];
#pragma unroll
                for (int w = 1; w < 8; ++w) acc += red[w * 64 + lane];
                const int n = lane & 15, kq = lane >> 4; const float* xo = (l == 0) ? p.x_sample : p.out + O_YS; float* xn = p.out + O_YS;
                if (kq < 2) {
#pragma unroll
                    for (int j = 0; j < 4; ++j) { const int row = 4 * kq + j; const size_t o = (size_t)row * DM + task * 16 + n; xn[o] = xo[o] + acc[j]; } } } }
        __syncthreads();
    }
}

#define XB_TMO      128
#define XB_XCNT(j)  (256  + 64 * (j))
#define XB_XSUB(j)  (1280 + 64 * (j))
#define XB_XGEN(j)  (2304 + 64 * (j))
#define XB_TOP      3328
#define XB_TOPGEN   3392
#define XCD_BAR_WORDS 3456
#define XB_SPIN_CAP (1u << 18)

__device__ __forceinline__ unsigned xb_ld(unsigned* p)              { return __hip_atomic_load(p, __ATOMIC_RELAXED, __HIP_MEMORY_SCOPE_AGENT); }
__device__ __forceinline__ unsigned xb_add(unsigned* p, unsigned v) { return __hip_atomic_fetch_add(p, v, __ATOMIC_RELAXED, __HIP_MEMORY_SCOPE_AGENT); }
__device__ __forceinline__ unsigned xb_xcc_id() { return (unsigned)__builtin_amdgcn_s_getreg((3 << 11) | 20) & 0xFu; }
#define XB_SPIN(cond, bar) do { unsigned _sp = 0; while (cond) { __builtin_amdgcn_s_sleep(1); \
    if ((++_sp & 255u) == 0u) { if (xb_ld(&(bar)[XB_TMO])) break; if (_sp > XB_SPIN_CAP) { atomicAdd(&(bar)[XB_TMO], 1u); break; } } } } while (0)

struct XcdBarrier {
    unsigned* bar; unsigned x;
    volatile LAS unsigned* st;
};

__device__ __forceinline__ XcdBarrier xcd_barrier_post(unsigned* bar, volatile LAS unsigned* st) {
    XcdBarrier b; b.bar = bar; b.x = xb_xcc_id(); b.st = st;
    if (threadIdx.x == 0) (void)xb_add(&bar[XB_XCNT(b.x)], 1u);
    return b;
}
__device__ __forceinline__ void xcd_barrier_complete(unsigned* bar, unsigned x, unsigned& nloc, unsigned& nx) {
    const unsigned G = gridDim.x * gridDim.y * gridDim.z;
    unsigned sum, cnt, mine, sp = 0u;
    for (;;) {
        sum = 0u; cnt = 0u; mine = 0u;
        unsigned cv[16];
        {
            const unsigned* cb = bar + XB_XCNT(0);
            asm volatile("global_load_dword %0, %16, off sc1\n\tglobal_load_dword %1, %16, off offset:256 sc1\n\tglobal_load_dword %2, %16, off offset:512 sc1\n\tglobal_load_dword %3, %16, off offset:768 sc1\n\t"
                         "global_load_dword %4, %16, off offset:1024 sc1\n\tglobal_load_dword %5, %16, off offset:1280 sc1\n\tglobal_load_dword %6, %16, off offset:1536 sc1\n\tglobal_load_dword %7, %16, off offset:1792 sc1\n\t"
                         "global_load_dword %8, %16, off offset:2048 sc1\n\tglobal_load_dword %9, %16, off offset:2304 sc1\n\tglobal_load_dword %10, %16, off offset:2560 sc1\n\tglobal_load_dword %11, %16, off offset:2816 sc1\n\t"
                         "global_load_dword %12, %16, off offset:3072 sc1\n\tglobal_load_dword %13, %16, off offset:3328 sc1\n\tglobal_load_dword %14, %16, off offset:3584 sc1\n\tglobal_load_dword %15, %16, off offset:3840 sc1\n\t"
                         "s_waitcnt vmcnt(0)"
                         : "=&v"(cv[0]), "=&v"(cv[1]), "=&v"(cv[2]), "=&v"(cv[3]), "=&v"(cv[4]), "=&v"(cv[5]), "=&v"(cv[6]), "=&v"(cv[7]),
                           "=&v"(cv[8]), "=&v"(cv[9]), "=&v"(cv[10]), "=&v"(cv[11]), "=&v"(cv[12]), "=&v"(cv[13]), "=&v"(cv[14]), "=&v"(cv[15])
                         : "v"(cb) : "memory");
        }
#pragma unroll
        for (unsigned j = 0; j < 16; ++j) { const unsigned c = cv[j]; sum += c; cnt += (c > 0u) ? 1u : 0u; mine = (j == x) ? c : mine; }
        if (sum == G) break;
        __builtin_amdgcn_s_sleep(1);
        if ((++sp & 255u) == 0u) { if (xb_ld(&bar[XB_TMO])) break; if (sp > XB_SPIN_CAP) { atomicAdd(&bar[XB_TMO], 1u); break; } }
    }
    nloc = mine > 0u ? mine : 1u; nx = cnt > 0u ? cnt : 1u;
}

__device__ __forceinline__ void xcd_barrier(const XcdBarrier& b) {
    asm volatile("s_waitcnt vmcnt(0)" ::: "memory");
    __syncthreads();
    if (threadIdx.x == 0) {
        unsigned* bar = b.bar;
        __builtin_amdgcn_s_waitcnt(0);
        unsigned nloc = b.st[0], nx = b.st[1];
        if (nloc == 0u) { xcd_barrier_complete(bar, b.x, nloc, nx); b.st[0] = nloc; b.st[1] = nx; }
        const unsigned old = xb_add(&bar[XB_XSUB(b.x)], 1u);
        const unsigned gen = old / nloc;
        if (old + 1u == (gen + 1u) * nloc) {
            __builtin_amdgcn_fence(__ATOMIC_RELEASE, "agent");
            asm volatile("s_waitcnt vmcnt(0)" ::: "memory");
            const unsigned og = xb_add(&bar[XB_TOP], 1u);
            const unsigned tg = og / nx;
            if (og + 1u == (tg + 1u) * nx) xb_add(&bar[XB_TOPGEN], 1u);
            else XB_SPIN(xb_ld(&bar[XB_TOPGEN]) == tg, bar);
            __builtin_amdgcn_fence(__ATOMIC_ACQUIRE, "agent");
            xb_add(&bar[XB_XGEN(b.x)], 1u);
            asm volatile("s_waitcnt vmcnt(0)" ::: "memory");
        } else {
            XB_SPIN(xb_ld(&bar[XB_XGEN(b.x)]) == gen, bar);
            __builtin_amdgcn_fence(__ATOMIC_ACQUIRE, "agent");
            asm volatile("s_waitcnt vmcnt(0)" ::: "memory");
        }
    }
    __syncthreads();
}

__global__ __launch_bounds__(512, 2) void mega(Params p, int ph_lo, int ph_hi, int coop) {
    extern __shared__ __attribute__((aligned(16))) unsigned char shm[];
    LAS unsigned char* lds = (LAS unsigned char*)shm;
    volatile LAS unsigned* xst = (volatile LAS unsigned*)(lds + (LDS_BYTES - 16));
    if (threadIdx.x < 2) xst[threadIdx.x] = 0u;
    __syncthreads();
    const XcdBarrier xb = xcd_barrier_post((unsigned*)(p.ws + W_BAR), xst);
    for (int ph = ph_lo; ph < ph_hi; ++ph) {
        int reps = 1;
#ifdef PROBE_PHASE
        if (ph == 0 ? (PROBE_PHASE == 0) : (((ph - 1) & 3) + 1 == PROBE_PHASE && (PROBE_PHASE != 4 || ph == 4))) reps = 2;
#endif
        for (int rep = 0; rep < reps; ++rep) {
            if (ph == 0) prep_phase(p, lds);
            else { const int l = (ph - 1) >> 2, s = (ph - 1) & 3;
                if (s == 0) phase_inproj(p, l, lds);
                else if (s == 1) phase_mix(p, l, lds);
                else if (s == 2) phase_combine(p, l, lds);
                else phase_outproj(p, l, lds); }
            if (coop && (ph + 1 < ph_hi || rep + 1 < reps)) {
                if (coop > 1) cg::this_grid().sync();
                else xcd_barrier(xb); }
        }
    }
}

extern "C" void kernel_launch(void* const* d_in, const int* in_sizes, int n_in, void* d_out, int out_size, void* d_ws, size_t ws_size, hipStream_t stream) {
    Params p{};
    p.x_prompt = (const float*)d_in[0]; p.x_sample = (const float*)d_in[1]; p.state_pool = (const float*)d_in[2]; p.c128 = (const float*)d_in[3];
    p.c512 = (const float*)d_in[4]; p.c2048 = (const float*)d_in[5]; p.cmem = (const float*)d_in[6]; p.mem_prompt = (const float*)d_in[7];
    p.norm_g = (const float*)d_in[8]; p.w_in = (const float*)d_in[9]; p.pool_w = (const float*)d_in[10]; p.pool_scale = (const float*)d_in[11];
    p.dil_q_norm = (const float*)d_in[12]; p.dil_k_norm = (const float*)d_in[13]; p.mem_norm_g = (const float*)d_in[14]; p.w_mem_kv = (const float*)d_in[15];
    p.mem_q_norm = (const float*)d_in[16]; p.mem_k_norm = (const float*)d_in[17]; p.w_out = (const float*)d_in[18];
    p.out = (float*)d_out; p.ws = (unsigned char*)d_ws;
    (void)hipFuncSetAttribute((const void*)mega, hipFuncAttributeMaxDynamicSharedMemorySize, LDS_BYTES);
    static int grid = 0;
    if (!grid) {
        int dev = 0, cus = 0, per_cu = 0;
        (void)hipGetDevice(&dev);
        (void)hipDeviceGetAttribute(&cus, hipDeviceAttributeMultiprocessorCount, dev);
        (void)hipOccupancyMaxActiveBlocksPerMultiprocessor(&per_cu, (const void*)mega, 512, LDS_BYTES);
        if (per_cu < 1) per_cu = 1;
        if (per_cu > 1) per_cu = 1;
        grid = cus * per_cu;
        if (grid > 256) grid = 256;
    }
    (void)hipMemsetAsync((unsigned char*)d_ws + W_BAR, 0, 16384, stream);
    int ph_lo = 0, ph_hi = NPHASE, coop = 1;
    void* args[] = {&p, &ph_lo, &ph_hi, &coop};
    hipError_t e = hipLaunchCooperativeKernel((const void*)mega, dim3(grid), dim3(512), args, LDS_BYTES, stream);
    if (e != hipSuccess) fprintf(stderr, "cooperative launch failed: %s (grid %d)\n", hipGetErrorString(e), grid);
}
```
